# Optimizing an MI355X kernel written in HIP

```python
import math
import jax, jax.numpy as jnp
from jax import lax
import numpy as np

D_MODEL = 1024
BATCH = 2
SEQ = 8192
DEPTH = 2

GRID_W = 64
CTX_LEN = 256
MLA_HEADS = 8
QK_NOPE = 64
QK_ROPE = 32
V_HEAD = 64
Q_LORA = 384
KV_LORA = 256
CONV_CH = 256
CONV_WIDTH = 31
SC_CH = 256
SC_WIDTH = 3
N_BRANCH = 3
D_FF = int(math.ceil(8 * D_MODEL / 3 / 256)) * 256
N_MOD = 6
ROPE_THETA = 10000.0
EPS = 1e-6
Q_BLOCK = 128

Q_A_END = Q_LORA
KV_A_END = Q_A_END + KV_LORA + QK_ROPE
GLU_END = KV_A_END + 2 * CONV_CH
SC_END = GLU_END + 3 * SC_CH
GATE_END = SC_END + N_BRANCH * D_MODEL
IN_COLS = GATE_END

kernel_name = 'hybrid_mla_conformer_shortconv_dit'


def rms_norm(x, g):
    xf = x.astype(jnp.float32)
    y = xf * lax.rsqrt(jnp.mean(xf * xf, axis=-1, keepdims=True) + EPS)
    return (y * g.astype(jnp.float32)).astype(x.dtype)


def layer_norm(x, g, b):
    xf = x.astype(jnp.float32)
    mu = jnp.mean(xf, axis=-1, keepdims=True)
    var = jnp.mean(jnp.square(xf - mu), axis=-1, keepdims=True)
    y = (xf - mu) * lax.rsqrt(var + EPS)
    return (y * g.astype(jnp.float32) + b.astype(jnp.float32)).astype(x.dtype)


def modulate(x, shift, scale):
    return x * (1 + scale) + shift


def depthwise_conv(u, w):
    k = w.shape[0]
    pad = (k - 1) // 2
    return lax.conv_general_dilated(
        u, w[:, None, :].astype(u.dtype), window_strides=(1,), padding=[(pad, pad)],
        dimension_numbers=('NWC', 'WIO', 'NWC'), feature_group_count=u.shape[-1])


def axial_rope_tables(n):
    rows = n // GRID_W
    row = jnp.repeat(jnp.arange(rows, dtype=jnp.float32), GRID_W)
    col = jnp.tile(jnp.arange(GRID_W, dtype=jnp.float32), rows)
    half = QK_ROPE // 2
    inv = jnp.power(jnp.float32(ROPE_THETA), -jnp.arange(0, half, 2, dtype=jnp.float32) / half)
    ang_r = row[:, None] * inv
    ang_c = col[:, None] * inv
    return (jnp.cos(ang_r), jnp.sin(ang_r), jnp.cos(ang_c), jnp.sin(ang_c))


def _rotate(x, cos, sin):
    x1, x2 = jnp.split(x, 2, axis=-1)
    return jnp.concatenate([x1 * cos - x2 * sin, x1 * sin + x2 * cos], axis=-1)


def apply_axial_rope(x, tables):
    extra = x.ndim - 3
    cr, sr, cc, sc = [t.reshape(t.shape[0], *([1] * extra), t.shape[1]).astype(x.dtype) for t in tables]
    xr, xc = jnp.split(x, 2, axis=-1)
    return jnp.concatenate([_rotate(xr, cr, sr), _rotate(xc, cc, sc)], axis=-1)


def mla_queries(q_a, q_norm_g, w_q_b):
    q = rms_norm(q_a, q_norm_g) @ w_q_b
    q = q.reshape(*q_a.shape[:-1], MLA_HEADS, QK_NOPE + QK_ROPE)
    return q[..., :QK_NOPE], q[..., QK_NOPE:]


def mla_keys_values(kv_a, kv_norm_g, w_kv_b):
    c_kv = rms_norm(kv_a[..., :KV_LORA], kv_norm_g)
    k_rope = kv_a[..., KV_LORA:]
    kv = (c_kv @ w_kv_b).reshape(*kv_a.shape[:-1], MLA_HEADS, QK_NOPE + V_HEAD)
    return kv[..., :QK_NOPE], k_rope, kv[..., QK_NOPE:]


def attend(q_nope, q_rope, k_nope, k_rope, v):
    scale = (QK_NOPE + QK_ROPE) ** -0.5
    s = jnp.einsum('bqhd,bkhd->bhqk', q_nope, k_nope) + jnp.einsum('bqhr,bkr->bhqk', q_rope, k_rope)
    p = jax.nn.softmax(s.astype(jnp.float32) * scale, axis=-1).astype(v.dtype)
    return jnp.einsum('bhqk,bkhd->bqhd', p, v)


def blockwise_attend(q_nope, q_rope, k_nope, k_rope, v):
    b, n = q_nope.shape[:2]
    nb = n // Q_BLOCK

    def to_blocks(t):
        return jnp.moveaxis(t.reshape(b, nb, Q_BLOCK, *t.shape[2:]), 1, 0)

    out = lax.map(lambda qs: attend(qs[0], qs[1], k_nope, k_rope, v),
                  (to_blocks(q_nope), to_blocks(q_rope)))
    return jnp.moveaxis(out, 0, 1).reshape(b, n, MLA_HEADS * V_HEAD)


def conformer_conv(glu_in, dw, dw_b, ln_g, ln_b, w_out):
    a, g = jnp.split(glu_in, 2, axis=-1)
    u = depthwise_conv(a * jax.nn.sigmoid(g), dw) + dw_b
    u = jax.nn.silu(layer_norm(u, ln_g, ln_b))
    return u @ w_out


def short_conv(sc_in, dw, w_out):
    bg, cg, xin = jnp.split(sc_in, 3, axis=-1)
    return (bg * depthwise_conv(cg * xin, dw)) @ w_out


def merge_branches(gate_in, y_att, y_conv, y_sc, w_o):
    g_att, g_conv, g_sc = jnp.split(jax.nn.sigmoid(gate_in), N_BRANCH, axis=-1)
    return (g_att * y_att + g_conv * y_conv + g_sc * y_sc) @ w_o


def swiglu(h, w1, w3, w2):
    return (jax.nn.silu(h @ w1) * (h @ w3)) @ w2


def setup_inputs(seed: int = 0) -> dict:
    key = jax.random.key(seed)
    ks = iter(jax.random.split(key, 32))

    def nrm(shape, scale):
        return jax.random.normal(next(ks), shape, jnp.float32) * scale

    def gain(shape):
        return 1.0 + nrm(shape, 0.02)

    return {
        'x': nrm((BATCH, SEQ, D_MODEL), 1.0),
        'c': nrm((BATCH, D_MODEL), 1.0),
        'ctx': nrm((BATCH, CTX_LEN, D_MODEL), 1.0),
        'c_ctx': nrm((D_MODEL,), 1.0),
        'w_mod': nrm((DEPTH, D_MODEL, N_MOD * D_MODEL), 0.5 * D_MODEL ** -0.5),
        'b_mod': nrm((DEPTH, N_MOD * D_MODEL), 0.01),
        'ln1_g': gain((DEPTH, D_MODEL)),
        'w_in': nrm((DEPTH, D_MODEL, IN_COLS), D_MODEL ** -0.5),
        'q_a_norm_g': gain((DEPTH, Q_LORA)),
        'w_q_b': nrm((DEPTH, Q_LORA, MLA_HEADS * (QK_NOPE + QK_ROPE)), Q_LORA ** -0.5),
        'kv_a_norm_g': gain((DEPTH, KV_LORA)),
        'w_kv_b': nrm((DEPTH, KV_LORA, MLA_HEADS * (QK_NOPE + V_HEAD)), KV_LORA ** -0.5),
        'w_mla_o': nrm((DEPTH, MLA_HEADS * V_HEAD, D_MODEL), (MLA_HEADS * V_HEAD) ** -0.5),
        'conv_dw': nrm((DEPTH, CONV_WIDTH, CONV_CH), CONV_WIDTH ** -0.5),
        'conv_dw_b': nrm((DEPTH, CONV_CH), 0.01),
        'conv_ln_g': gain((DEPTH, CONV_CH)),
        'conv_ln_b': nrm((DEPTH, CONV_CH), 0.01),
        'w_conv_o': nrm((DEPTH, CONV_CH, D_MODEL), CONV_CH ** -0.5),
        'sc_dw': nrm((DEPTH, SC_WIDTH, SC_CH), SC_WIDTH ** -0.5),
        'w_sc_o': nrm((DEPTH, SC_CH, D_MODEL), SC_CH ** -0.5),
        'w_o': nrm((DEPTH, D_MODEL, D_MODEL), D_MODEL ** -0.5),
        'ln2_g': gain((DEPTH, D_MODEL)),
        'w_ff1': nrm((DEPTH, D_MODEL, D_FF), D_MODEL ** -0.5),
        'w_ff3': nrm((DEPTH, D_MODEL, D_FF), D_MODEL ** -0.5),
        'w_ff2': nrm((DEPTH, D_FF, D_MODEL), D_FF ** -0.5),
        'final_g': gain((D_MODEL,)),
    }


def reference(x, c, ctx, c_ctx, w_mod, b_mod, ln1_g, w_in, q_a_norm_g, w_q_b, kv_a_norm_g,
              w_kv_b, w_mla_o, conv_dw, conv_dw_b, conv_ln_g, conv_ln_b, w_conv_o, sc_dw, w_sc_o,
              w_o, ln2_g, w_ff1, w_ff3, w_ff2, final_g):
    b, n, _ = x.shape
    n_ctx = ctx.shape[1]
    rope = axial_rope_tables(n)
    c_act = jax.nn.silu(c)
    cc_act = jax.nn.silu(c_ctx)
    xc = ctx
    for l in range(DEPTH):
        last = l == DEPTH - 1
        sh1, sc1, g1, sh2, sc2, g2 = jnp.split((c_act @ w_mod[l] + b_mod[l])[:, None, :], N_MOD, axis=-1)
        mod_c = jnp.split(cc_act @ w_mod[l] + b_mod[l], N_MOD, axis=-1)

        hc = modulate(rms_norm(xc, ln1_g[l]), mod_c[0], mod_c[1])
        if last:
            kvc_a = hc @ w_in[l][:, Q_A_END:KV_A_END]
        else:
            projc = hc @ w_in[l]
            kvc_a = projc[..., Q_A_END:KV_A_END]
        kc_nope, kc_rope, vc = mla_keys_values(kvc_a, kv_a_norm_g[l], w_kv_b[l])
        if not last:
            qc_nope, qc_rope = mla_queries(projc[..., :Q_A_END], q_a_norm_g[l], w_q_b[l])
            att_c = attend(qc_nope, qc_rope, kc_nope, kc_rope, vc).reshape(b, n_ctx, MLA_HEADS * V_HEAD) @ w_mla_o[l]
            conv_c = conformer_conv(projc[..., KV_A_END:GLU_END], conv_dw[l], conv_dw_b[l],
                                    conv_ln_g[l], conv_ln_b[l], w_conv_o[l])
            scv_c = short_conv(projc[..., GLU_END:SC_END], sc_dw[l], w_sc_o[l])
            xc = xc + mod_c[2] * merge_branches(projc[..., SC_END:GATE_END], att_c, conv_c, scv_c, w_o[l])
            hc2 = modulate(rms_norm(xc, ln2_g[l]), mod_c[3], mod_c[4])
            xc = xc + mod_c[5] * swiglu(hc2, w_ff1[l], w_ff3[l], w_ff2[l])

        h = modulate(rms_norm(x, ln1_g[l]), sh1, sc1)
        proj = h @ w_in[l]
        q_nope, q_rope = mla_queries(proj[..., :Q_A_END], q_a_norm_g[l], w_q_b[l])
        k_nope, k_rope, v = mla_keys_values(proj[..., Q_A_END:KV_A_END], kv_a_norm_g[l], w_kv_b[l])
        q_rope = apply_axial_rope(q_rope, rope)
        k_rope = apply_axial_rope(k_rope, rope)
        att = blockwise_attend(q_nope, q_rope,
                               jnp.concatenate([k_nope, kc_nope], axis=1),
                               jnp.concatenate([k_rope, kc_rope], axis=1),
                               jnp.concatenate([v, vc], axis=1)) @ w_mla_o[l]
        y_conv = conformer_conv(proj[..., KV_A_END:GLU_END], conv_dw[l], conv_dw_b[l],
                                conv_ln_g[l], conv_ln_b[l], w_conv_o[l])
        y_sc = short_conv(proj[..., GLU_END:SC_END], sc_dw[l], w_sc_o[l])
        x = x + g1 * merge_branches(proj[..., SC_END:GATE_END], att, y_conv, y_sc, w_o[l])
        h2 = modulate(rms_norm(x, ln2_g[l]), sh2, sc2)
        x = x + g2 * swiglu(h2, w_ff1[l], w_ff3[l], w_ff2[l])
    return rms_norm(x, final_g)
```

```cpp
#include <hip/hip_runtime.h>
#include <hip/hip_cooperative_groups.h>
#include <cstdio>
#include <cstdint>
#ifndef ONLY_GEMM
#define ONLY_GEMM 0
#endif
#ifndef REPMASK
#define REPMASK 0
#endif
#ifndef NSYNC_EXTRA
#define NSYNC_EXTRA 0
#endif
#ifndef MK_MULTI
#define MK_MULTI 0
#endif
namespace cg = cooperative_groups;
__device__ __forceinline__ int tid_fresh() { int t = threadIdx.x; asm volatile("" : "+v"(t)); return t; }
namespace pg8 {
#define PG8_LAS __attribute__((address_space(3)))
typedef unsigned short bf16_t;
typedef short bf16x8 __attribute__((ext_vector_type(8)));
typedef float f32x4 __attribute__((ext_vector_type(4)));
typedef unsigned u32x4 __attribute__((ext_vector_type(4)));
constexpr int BM = 256, BK = 64, HALF = 128, HTB = HALF * BK * 2  , STAGE_BYTES = 8 * HTB, NXCD = 8, WGM = 8;

__host__ __device__ __forceinline__ int lds_byte(int r, int c) { const int st = (r >> 4) * 2 + (c >> 5), rr = r & 15, cc = c & 31, ob = rr * 64 + cc * 2; return st * 1024 + (ob ^ (((ob >> 9) & 1) << 5)); }
__host__ __device__ __forceinline__ void stage_rc(int b, int& R, int& C) { const int st = b / 1024, sb = b % 1024, swz = sb ^ (((sb >> 9) & 1) << 5); R = (st >> 1) * 16 + swz / 64; C = (st & 1) * 32 + (swz % 64) / 2; }
__host__ __device__ __forceinline__ int perm32(int rho) { const int n = rho >> 4, i = rho & 15; return 8 * (i >> 2) + 4 * n + (i & 3); }

struct Unit { int pm, pn, ko; };
struct Gemm { const bf16_t* A; const bf16_t* Bt; int M, N, K, ld; };

struct StaticOrder {
    int nM, nN, nwg, G, c;
    __host__ __device__ void init(int M, int N, int G_, int c_) { nM = M / BM; nN = N / BM; nwg = nM * nN; G = G_; c = c_; }
    __host__ __device__ bool next(int i, Unit& u) const {
        const long L = (long)i * G + c; if (L >= nwg) return false;
        int wgid = (int)L; { const int q = nwg / NXCD, r = nwg % NXCD, xcd = wgid % NXCD, off = wgid / NXCD; wgid = (xcd < r ? xcd * (q + 1) : r * (q + 1) + (xcd - r) * q) + off; }
        const int nig = WGM * nN, gid = wgid / nig, fm = gid * WGM, gsz = (nM - fm) < WGM ? (nM - fm) : WGM;
        u.pm = fm + ((wgid % nig) % gsz); u.pn = (wgid % nig) / gsz; u.ko = 0; return true;
    }
    __device__ __forceinline__ void a_ready(const Unit&) const {}
    __device__ __forceinline__ void done(const Unit&) const {}
};

__device__ __forceinline__ unsigned cvt_pk_bf16(float lo, float hi) { unsigned r; asm volatile("v_cvt_pk_bf16_f32 %0, %1, %2" : "=v"(r) : "v"(lo), "v"(hi)); return r; }
typedef float f32x2 __attribute__((ext_vector_type(2)));
template <class Epi, class Sched, bool ALIGN_EPI = false, bool SP2 = false>
__device__ __forceinline__ void gemm_phase(PG8_LAS unsigned char* lds, const Gemm g, const Sched& S, const Epi& E) {
    const int tid = tid_fresh(), wid = __builtin_amdgcn_readfirstlane(tid >> 6), lane = tid & 63, wr = wid >> 2, wc = wid & 3, fr = lane & 15, fq = lane >> 4;
    const int K = g.K, nt = K / BK, LD = g.ld;
    unsigned voffA[2], voffB[2];
#pragma unroll
    for (int i = 0; i < 2; ++i) { int R, C; stage_rc(tid * 16 + i * 8192, R, C); const int Rb = Epi::PERM ? ((R & ~31) + perm32(R & 31)) : R;
        voffA[i] = (unsigned)(R * LD + C) * 2u; voffB[i] = (unsigned)(Rb * LD + C) * 2u; }
    const size_t kstep = (size_t)(BK * 2);
    const size_t hstep = (size_t)HALF * LD * 2;
    const size_t tstep = 2 * hstep;
    const unsigned ldsw = (unsigned)wid * 1024u;
    const int aoff = lds_byte(wr * 64 + fr, fq * 8), boff = lds_byte(wc * 32 + fr, fq * 8);
#define PG8_SA(b, h) (((b) * 2 + (h)) * HTB)
#define PG8_SB(b, h) ((4 + (b) * 2 + (h)) * HTB)
#define PG8_STAGE(bufoff, gbase, voff) do { _Pragma("unroll") for (int _i = 0; _i < 2; ++_i) \
        __builtin_amdgcn_global_load_lds((const unsigned*)((const char*)(gbase) + (voff)[_i]), (PG8_LAS unsigned*)(lds + (bufoff) + ldsw + _i * 8192), 16, 0, 0); } while (0)
#define PG8_LDA(dst, b, h) do { _Pragma("unroll") for (int m = 0; m < 4; ++m) _Pragma("unroll") for (int k = 0; k < 2; ++k) dst[m][k] = *(const PG8_LAS bf16x8*)(lds + PG8_SA(b, h) + aoff + m * 2048 + k * 1024); } while (0)
#define PG8_LDB(dst, b, h) do { _Pragma("unroll") for (int n = 0; n < 2; ++n) _Pragma("unroll") for (int k = 0; k < 2; ++k) dst[n][k] = *(const PG8_LAS bf16x8*)(lds + PG8_SB(b, h) + boff + n * 2048 + k * 1024); } while (0)
#define PG8_MMA(ai, bj, At, Bt) do { __builtin_amdgcn_s_setprio(1); _Pragma("unroll") for (int m = 0; m < 4; ++m) _Pragma("unroll") for (int n = 0; n < 2; ++n) _Pragma("unroll") for (int k = 0; k < 2; ++k) \
        acc[ai][bj][m][n] = __builtin_amdgcn_mfma_f32_16x16x32_bf16(Bt[n][k], At[m][k], acc[ai][bj][m][n], 0, 0, 0); __builtin_amdgcn_s_setprio(0); } while (0)
#define PG8_WAIT_V(n) asm volatile("s_waitcnt vmcnt(" #n ")" ::: "memory")
#define PG8_WAIT_L(n) asm volatile("s_waitcnt lgkmcnt(" #n ")" ::: "memory")
#define PG8_BAR __builtin_amdgcn_s_barrier()
#define PG8_SCHED __builtin_amdgcn_sched_barrier(0)
    Unit cur, nxt; int ui = 0;
    if (!S.next(0, cur)) return;
    f32x4 acc[2][2][4][2];
#pragma unroll
    for (int a = 0; a < 2; ++a)
#pragma unroll
        for (int b = 0; b < 2; ++b)
#pragma unroll
            for (int m = 0; m < 4; ++m)
#pragma unroll
                for (int n = 0; n < 2; ++n) acc[a][b][m][n] = (f32x4){0.f, 0.f, 0.f, 0.f};
    bf16x8 At[4][2], B0[2][2], B1[2][2];
    const char* cA = (const char*)g.A + (size_t)cur.pm * tstep + (size_t)cur.ko * 2; const char* cB = (const char*)g.Bt + (size_t)cur.pn * tstep + (size_t)cur.ko * 2;
    S.a_ready(cur);
    if constexpr (SP2) {
        PG8_STAGE(PG8_SB(0, 0), cB, voffB); PG8_STAGE(PG8_SB(0, 1), cB + hstep, voffB); PG8_STAGE(PG8_SA(0, 0), cA, voffA); PG8_STAGE(PG8_SA(0, 1), cA + hstep, voffA);
        if (wr == 1) PG8_BAR;
        PG8_WAIT_V(2); PG8_BAR;
        PG8_STAGE(PG8_SB(1, 0), cB + kstep, voffB); PG8_STAGE(PG8_SA(1, 0), cA + kstep, voffA); PG8_STAGE(PG8_SB(1, 1), cB + hstep + kstep, voffB);
        PG8_WAIT_V(6); PG8_BAR;
    } else {
        PG8_STAGE(PG8_SB(0, 0), cB, voffB); PG8_STAGE(PG8_SA(0, 0), cA, voffA); PG8_STAGE(PG8_SB(0, 1), cB + hstep, voffB); PG8_STAGE(PG8_SA(0, 1), cA + hstep, voffA);
        if (wr == 1) PG8_BAR;
        PG8_WAIT_V(4); PG8_BAR;
        PG8_STAGE(PG8_SB(1, 0), cB + kstep, voffB); PG8_STAGE(PG8_SA(1, 0), cA + kstep, voffA); PG8_STAGE(PG8_SB(1, 1), cB + hstep + kstep, voffB);
        PG8_WAIT_V(6); PG8_BAR;
    }
    for (;;) {
        const bool has_next = S.next(ui + 1, nxt);
        const char* nA = has_next ? (const char*)g.A + (size_t)nxt.pm * tstep + (size_t)nxt.ko * 2 : cA; const char* nB = has_next ? (const char*)g.Bt + (size_t)nxt.pn * tstep + (size_t)nxt.ko * 2 : cB;
#pragma unroll 1
        for (int t = 0; t < nt; t += 2) {
            const bool last = (t == nt - 2);
            const char* a1 = cA + (size_t)(t + 1) * kstep;
            const char* a2 = last ? nA : cA + (size_t)(t + 2) * kstep; const char* b2 = last ? nB : cB + (size_t)(t + 2) * kstep;
            const char* a3 = a2 + kstep; const char* b3 = b2 + kstep;
            if (last && has_next) S.a_ready(nxt);
            if constexpr (SP2) {
            PG8_LDB(B0, 0, 0); PG8_LDB(B1, 0, 1); PG8_SCHED; PG8_LDA(At, 0, 0); PG8_STAGE(PG8_SA(1, 1), a1 + hstep, voffA);
            PG8_WAIT_V(8); PG8_WAIT_L(0); PG8_BAR; PG8_MMA(0, 0, At, B0); PG8_MMA(0, 1, At, B1); PG8_BAR; PG8_SCHED;
            PG8_LDA(At, 0, 1); PG8_STAGE(PG8_SB(0, 0), b2, voffB); PG8_STAGE(PG8_SB(0, 1), b2 + hstep, voffB); PG8_STAGE(PG8_SA(0, 0), a2, voffA);
            PG8_WAIT_V(8); PG8_WAIT_L(0); PG8_BAR; PG8_MMA(1, 0, At, B0); PG8_MMA(1, 1, At, B1); PG8_BAR; PG8_SCHED;
            PG8_LDB(B0, 1, 0); PG8_LDB(B1, 1, 1); PG8_SCHED; PG8_LDA(At, 1, 0); PG8_STAGE(PG8_SA(0, 1), a2 + hstep, voffA);
            PG8_WAIT_V(8); PG8_WAIT_L(0); PG8_BAR; PG8_MMA(0, 0, At, B0); PG8_MMA(0, 1, At, B1); PG8_BAR; PG8_SCHED;
            PG8_LDA(At, 1, 1); PG8_STAGE(PG8_SB(1, 0), b3, voffB); PG8_STAGE(PG8_SB(1, 1), b3 + hstep, voffB); PG8_STAGE(PG8_SA(1, 0), a3, voffA);
            PG8_WAIT_V(8); PG8_WAIT_L(0); PG8_BAR; PG8_MMA(1, 0, At, B0); PG8_MMA(1, 1, At, B1); PG8_BAR; PG8_SCHED;
            } else {
            PG8_LDB(B0, 0, 0); PG8_SCHED; PG8_LDA(At, 0, 0); PG8_STAGE(PG8_SA(1, 1), a1 + hstep, voffA);
            PG8_WAIT_L(8); PG8_BAR; PG8_WAIT_L(0); PG8_MMA(0, 0, At, B0); PG8_BAR; PG8_SCHED;
            PG8_LDB(B1, 0, 1); PG8_STAGE(PG8_SB(0, 0), b2, voffB);
            PG8_BAR; PG8_WAIT_L(0); PG8_MMA(0, 1, At, B1); PG8_BAR;
            PG8_LDA(At, 0, 1); PG8_STAGE(PG8_SA(0, 0), a2, voffA);
            PG8_BAR; PG8_WAIT_L(0); PG8_MMA(1, 0, At, B0); PG8_BAR; PG8_SCHED;
            PG8_STAGE(PG8_SB(0, 1), b2 + hstep, voffB);
            PG8_WAIT_V(6); PG8_BAR; PG8_MMA(1, 1, At, B1); PG8_BAR;
            PG8_LDB(B0, 1, 0); PG8_SCHED; PG8_LDA(At, 1, 0); PG8_STAGE(PG8_SA(0, 1), a2 + hstep, voffA);
            PG8_WAIT_L(8); PG8_BAR; PG8_WAIT_L(0); PG8_MMA(0, 0, At, B0); PG8_BAR; PG8_SCHED;
            PG8_LDB(B1, 1, 1); PG8_STAGE(PG8_SB(1, 0), b3, voffB);
            PG8_BAR; PG8_WAIT_L(0); PG8_MMA(0, 1, At, B1); PG8_BAR;
            PG8_LDA(At, 1, 1); PG8_STAGE(PG8_SA(1, 0), a3, voffA);
            PG8_BAR; PG8_WAIT_L(0); PG8_MMA(1, 0, At, B0); PG8_BAR; PG8_SCHED;
            PG8_STAGE(PG8_SB(1, 1), b3 + hstep, voffB);
            PG8_WAIT_V(6); PG8_BAR; PG8_MMA(1, 1, At, B1); PG8_BAR;
            }
        }
        if constexpr (ALIGN_EPI) { if (wr == 0) PG8_BAR; }
        if constexpr (!Epi::AFTER_DRAIN) { E(acc, cur, wr, wc, fr, fq); S.done(cur); }
        if (!has_next) break;
#pragma unroll
        for (int a = 0; a < 2; ++a)
#pragma unroll
            for (int b = 0; b < 2; ++b)
#pragma unroll
                for (int m = 0; m < 4; ++m)
#pragma unroll
                    for (int n = 0; n < 2; ++n) acc[a][b][m][n] = (f32x4){0.f, 0.f, 0.f, 0.f};
        cur = nxt; cA = nA; cB = nB; ++ui;
        if constexpr (ALIGN_EPI) { if (wr == 1) PG8_BAR; }
    }
    PG8_WAIT_V(0);
    if constexpr (!ALIGN_EPI) { if (wr == 0) PG8_BAR; }
    PG8_BAR;
    if constexpr (Epi::AFTER_DRAIN) { E.fused(acc, cur, wr, wc, fr, fq, lds, wid, lane); S.done(cur); }
#undef PG8_SA
#undef PG8_SB
#undef PG8_STAGE
#undef PG8_LDA
#undef PG8_LDB
#undef PG8_MMA
#undef PG8_WAIT_V
#undef PG8_WAIT_L
#undef PG8_BAR
#undef PG8_SCHED
}
}

namespace mk {
using pg8::bf16_t; using pg8::bf16x8; using pg8::f32x4; using pg8::u32x4; using pg8::cvt_pk_bf16;
typedef float f32x2 __attribute__((ext_vector_type(2)));
typedef unsigned u32x2 __attribute__((ext_vector_type(2)));
typedef float f32x16 __attribute__((ext_vector_type(16)));
typedef float f32x8 __attribute__((ext_vector_type(8)));
typedef short s16x4 __attribute__((ext_vector_type(4)));
#define LAS __attribute__((address_space(3)))

constexpr int D = 1024, SEQ = 8192, NB = 2, CTX = 256, DEPTH = 2;
constexpr int ML = NB * SEQ, MC = NB * CTX, MT = ML + MC;
constexpr int NH = 8, DQK = 96, DV = 64, QLORA = 384, KVLORA = 256, NKEY = SEQ + CTX;
constexpr int INC = 5024, NP1 = 2048, NGATE = 3072, NIN = 5120, DFF = 2816, NMOD = 6144;
constexpr float EPS = 1e-6f;
constexpr float ATT_SCALE = 0.10206207261596577f;
constexpr float QSCALE = ATT_SCALE * 1.4426950408889634f;
constexpr size_t MiB = 1u << 20;
constexpr size_t WS_MOD = 0;
constexpr size_t WS_BAR = 148 * 1024;
constexpr size_t WS_ZERO_BYTES = 192 * 1024;
constexpr size_t WS_ROPE = 192 * 1024;
constexpr size_t WS_XCTX = 1 * MiB;
constexpr size_t WS_W = 3 * MiB;
constexpr size_t W_IN = 0, W_Q = W_IN + (size_t)NIN * D * 2, W_KV = W_Q + (size_t)768 * QLORA * 2, W_MO = W_KV + (size_t)1024 * KVLORA * 2,
                 W_CO = W_MO + (size_t)1024 * 512 * 2, W_SO = W_CO + (size_t)1024 * 256 * 2, W_O = W_SO + (size_t)1024 * 256 * 2,
                 W_13 = W_O + (size_t)1024 * 1024 * 2, W_2 = W_13 + (size_t)2 * DFF * D * 2, W_END = W_2 + (size_t)D * DFF * 2;
static_assert(WS_BAR + 3456 * 4 <= WS_ZERO_BYTES && WS_BAR >= 147456, "ctl");
static_assert(WS_W + W_END <= 36 * MiB, "weights");
constexpr size_t WS_GATES = 36 * MiB;
constexpr size_t WS_R = 135 * MiB;
static_assert(WS_GATES + (size_t)MT * NGATE * 2 <= WS_R, "gates");
constexpr size_t WS_P1 = WS_R;
constexpr size_t WS_Q = WS_R, WS_K = WS_Q + (size_t)NB * NH * NKEY * DQK * 2, WS_V = WS_K + (size_t)NB * NH * NKEY * DQK * 2;
constexpr size_t WS_T = WS_R;
constexpr size_t WS_PB = WS_R + 34 * MiB;
constexpr size_t WS_H = WS_R + 66 * MiB;
static_assert(WS_V + (size_t)NB * NH * NKEY * DV * 2 <= WS_H && WS_P1 + (size_t)MT * NP1 * 2 <= WS_H, "P1/QKV");
constexpr size_t WS_QN = WS_H;
constexpr size_t WS_CKV = WS_QN + (size_t)MT * QLORA * 2, WS_CACT = WS_CKV + (size_t)MT * 256 * 2, WS_SACT = WS_CACT + (size_t)MT * 256 * 2,
                 WS_ATT = WS_SACT + (size_t)MT * 256 * 2, WS_KR = WS_ATT + (size_t)MT * 512 * 2, WS_END = WS_KR + (size_t)MT * 32 * 2;
static_assert(WS_END <= 256 * MiB, "workspace");
static_assert(WS_PB >= WS_T + (size_t)MT * D * 2 && WS_PB + (size_t)11 * MC * D * 4 <= WS_H, "PB");

constexpr int LDS_BYTES = 147456;

struct Params {
    const float *x, *c, *ctx, *c_ctx, *w_mod, *b_mod, *ln1_g, *w_in, *q_g, *w_q_b, *kv_g, *w_kv_b, *w_mla_o, *conv_dw, *conv_dw_b, *conv_ln_g, *conv_ln_b,
                *w_conv_o, *sc_dw, *w_sc_o, *w_o, *ln2_g, *w_ff1, *w_ff3, *w_ff2, *final_g;
    float* out; unsigned char* ws;
    int ph_lo, ph_hi;
};

__device__ __forceinline__ float wave_sum(float v) {
#pragma unroll
    for (int o = 1; o < 64; o <<= 1) v += __shfl_xor(v, o);
    return v;
}
__device__ __forceinline__ float bf2f(unsigned short b) { return __uint_as_float((unsigned)b << 16); }
__device__ __forceinline__ float bflo(unsigned w) { return __uint_as_float(w << 16); }
__device__ __forceinline__ float bfhi(unsigned w) { return __uint_as_float(w & 0xffff0000u); }
__device__ __forceinline__ float sigmoidf_(float x) { return __builtin_amdgcn_rcpf(1.f + __builtin_amdgcn_exp2f(-1.4426950408889634f * x)); }
__device__ __forceinline__ float siluf_(float x) { return x * sigmoidf_(x); }
__device__ __forceinline__ int rowgroup(int pm) { return pm < 32 ? 0 : (pm < 64 ? 1 : 2); }

struct EpiProj {
    static constexpr bool PERM = true, AFTER_DRAIN = false;
    bf16_t* P1; bf16_t* G;
    __device__ __forceinline__ void operator()(const f32x4 (&acc)[2][2][4][2], const pg8::Unit& u, int wr, int wc, int fr, int fq) const {
        const int row0 = u.pm * 256 + wr * 64 + fr; const bool gate = u.pn >= 8;
        bf16_t* base = gate ? G + (size_t)row0 * NGATE + (u.pn - 8) * 256 + wc * 32 + fq * 8 : P1 + (size_t)row0 * NP1 + u.pn * 256 + wc * 32 + fq * 8;
        const size_t ld = gate ? NGATE : NP1;
#pragma unroll
        for (int ai = 0; ai < 2; ++ai)
#pragma unroll
            for (int m = 0; m < 4; ++m) { bf16_t* rp = base + (size_t)(ai * 128 + m * 16) * ld;
#pragma unroll
                for (int bj = 0; bj < 2; ++bj) { f32x4 v0 = acc[ai][bj][m][0], v1 = acc[ai][bj][m][1];
                    if (gate) {
#pragma unroll
                        for (int i = 0; i < 4; ++i) { v0[i] = sigmoidf_(v0[i]); v1[i] = sigmoidf_(v1[i]); } }
                    u32x4 w; w.x = cvt_pk_bf16(v0[0], v0[1]); w.y = cvt_pk_bf16(v0[2], v0[3]); w.z = cvt_pk_bf16(v1[0], v1[1]); w.w = cvt_pk_bf16(v1[2], v1[3]);
                    *(u32x4*)(rp + bj * 128) = w; } }
    }
};
__device__ __forceinline__ void row_to_bq(int row, int& b, int& qi) { if (row < ML) { b = row >> 13; qi = row & (SEQ - 1); } else { const int r2 = row - ML; b = r2 >> 8; qi = SEQ + (r2 & 255); } }

struct EpiQ {
    static constexpr bool PERM = true, AFTER_DRAIN = false;
    bf16_t* Q; const float* rope;
    __device__ __forceinline__ void operator()(const f32x4 (&acc)[2][2][4][2], const pg8::Unit& u, int wr, int wc, int fr, int fq) const {
        const bool latent = u.pm < 64;
#pragma unroll
        for (int bj = 0; bj < 2; ++bj) {
            const int g32 = 8 * u.pn + 4 * bj + wc, h = g32 / 3, sub = g32 - 3 * h; const int d0 = sub * 32 + fq * 8;
            const bool dorope = latent && (sub == 2);
#pragma unroll
            for (int ai = 0; ai < 2; ++ai)
#pragma unroll
                for (int m = 0; m < 4; ++m) {
                    const int row = u.pm * 256 + ai * 128 + wr * 64 + m * 16 + fr; int b, qi; row_to_bq(row, b, qi);
                    f32x4 v0 = acc[ai][bj][m][0], v1 = acc[ai][bj][m][1];
                    if (dorope) {
                        const int pos = (fq >> 1) ? (qi & 63) : (qi >> 6); const bool isx2 = fq & 1;
                        const f32x4 c0 = *(const f32x4*)(rope + pos * 8), c1 = *(const f32x4*)(rope + pos * 8 + 4), s0 = *(const f32x4*)(rope + 1024 + pos * 8), s1 = *(const f32x4*)(rope + 1024 + pos * 8 + 4);
#pragma unroll
                        for (int i = 0; i < 4; ++i) {
                            const float p0 = __shfl_xor(v0[i], 16), p1 = __shfl_xor(v1[i], 16);
                            v0[i] = isx2 ? p0 * s0[i] + v0[i] * c0[i] : v0[i] * c0[i] - p0 * s0[i];
                            v1[i] = isx2 ? p1 * s1[i] + v1[i] * c1[i] : v1[i] * c1[i] - p1 * s1[i]; }
                    }
                    v0 = v0 * QSCALE; v1 = v1 * QSCALE;
                    u32x4 w; w.x = cvt_pk_bf16(v0[0], v0[1]); w.y = cvt_pk_bf16(v0[2], v0[3]); w.z = cvt_pk_bf16(v1[0], v1[1]); w.w = cvt_pk_bf16(v1[2], v1[3]);
                    *(u32x4*)(Q + ((size_t)(b * NH + h) * NKEY + qi) * DQK + d0) = w; asm volatile("" ::: "memory"); }
        }
    }
};
struct EpiKV {
    static constexpr bool PERM = true, AFTER_DRAIN = false;
    bf16_t* K; bf16_t* V; const bf16_t* KR;
    __device__ __forceinline__ void operator()(const f32x4 (&acc)[2][2][4][2], const pg8::Unit& u, int wr, int wc, int fr, int fq) const {
#pragma unroll
        for (int bj = 0; bj < 2; ++bj) { const int h = 2 * u.pn + bj; const int jp = wc * 32 + fq * 8;
#pragma unroll
            for (int ai = 0; ai < 2; ++ai)
#pragma unroll
                for (int m = 0; m < 4; ++m) {
                    const int row = u.pm * 256 + ai * 128 + wr * 64 + m * 16 + fr; int b, qi; row_to_bq(row, b, qi);
                    const f32x4 v0 = acc[ai][bj][m][0], v1 = acc[ai][bj][m][1];
                    u32x4 w; w.x = cvt_pk_bf16(v0[0], v0[1]); w.y = cvt_pk_bf16(v0[2], v0[3]); w.z = cvt_pk_bf16(v1[0], v1[1]); w.w = cvt_pk_bf16(v1[2], v1[3]);
                    bf16_t* dst = (wc < 2) ? K + ((size_t)(b * NH + h) * NKEY + qi) * DQK + jp : V + ((size_t)(b * NH + h) * NKEY + qi) * DV + (jp - 64);
                    *(u32x4*)dst = w;
                    if (wc == 0) *(u32x4*)(K + ((size_t)(b * NH + h) * NKEY + qi) * DQK + 64 + fq * 8) = *(const u32x4*)(KR + (size_t)row * 32 + fq * 8);
                    asm volatile("" ::: "memory"); }
        }
    }
};
template <int MODE> struct EpiMerge {
    static constexpr bool PERM = true, AFTER_DRAIN = false;
    bf16_t* T; const bf16_t* G; int br;
    __device__ __forceinline__ void operator()(const f32x4 (&acc)[2][2][4][2], const pg8::Unit& u, int wr, int wc, int fr, int fq) const {
#pragma unroll
        for (int ai = 0; ai < 2; ++ai)
#pragma unroll
            for (int m = 0; m < 4; ++m) { const int row = u.pm * 256 + ai * 128 + wr * 64 + m * 16 + fr;
#pragma unroll
                for (int bj = 0; bj < 2; ++bj) { const int col = u.pn * 256 + bj * 128 + wc * 32 + fq * 8;
                    const u32x4 gw = *(const u32x4*)(G + (size_t)row * NGATE + br * 1024 + col);
                    const f32x4 a0 = acc[ai][bj][m][0], a1 = acc[ai][bj][m][1];
                    float r[8] = {bflo(gw.x) * a0[0], bfhi(gw.x) * a0[1], bflo(gw.y) * a0[2], bfhi(gw.y) * a0[3], bflo(gw.z) * a1[0], bfhi(gw.z) * a1[1], bflo(gw.w) * a1[2], bfhi(gw.w) * a1[3]};
                    bf16_t* tp = T + (size_t)row * D + col;
                    if (MODE == 1) { const u32x4 tw = *(const u32x4*)tp;
                        r[0] += bflo(tw.x); r[1] += bfhi(tw.x); r[2] += bflo(tw.y); r[3] += bfhi(tw.y); r[4] += bflo(tw.z); r[5] += bfhi(tw.z); r[6] += bflo(tw.w); r[7] += bfhi(tw.w); }
                    u32x4 w; w.x = cvt_pk_bf16(r[0], r[1]); w.y = cvt_pk_bf16(r[2], r[3]); w.z = cvt_pk_bf16(r[4], r[5]); w.w = cvt_pk_bf16(r[6], r[7]);
                    *(u32x4*)tp = w; } asm volatile("" ::: "memory"); }
    }
};
struct EpiResid {
    static constexpr bool PERM = true, AFTER_DRAIN = false;
    const float* inL; const float* inC; float* outL; float* outC; const float* gvec;
    __device__ __forceinline__ void operator()(const f32x4 (&acc)[2][2][4][2], const pg8::Unit& u, int wr, int wc, int fr, int fq) const {
        const bool lat = u.pm < 64; const float* gp = gvec + rowgroup(u.pm) * NMOD;
        const float* ib = lat ? inL : inC - (size_t)ML * D; float* ob = lat ? outL : outC - (size_t)ML * D;
#pragma unroll
        for (int bj = 0; bj < 2; ++bj) { const int col = u.pn * 256 + bj * 128 + wc * 32 + fq * 8;
            const f32x4 g0 = *(const f32x4*)(gp + col), g1 = *(const f32x4*)(gp + col + 4);
#pragma unroll
            for (int ai = 0; ai < 2; ++ai)
#pragma unroll
                for (int m = 0; m < 4; ++m) { const int row = u.pm * 256 + ai * 128 + wr * 64 + m * 16 + fr; const size_t off = (size_t)row * D + col;
                    const f32x4 x0 = *(const f32x4*)(ib + off), x1 = *(const f32x4*)(ib + off + 4);
                    *(f32x4*)(ob + off) = x0 + g0 * acc[ai][bj][m][0]; *(f32x4*)(ob + off + 4) = x1 + g1 * acc[ai][bj][m][1]; }
        }
    }
};
struct CtxSplitOrder {
    int nsplit, G, c;
    __device__ bool next(int i, pg8::Unit& u) const { const int L = i * G + c; if (L >= 8 * nsplit) return false; u.pm = 64 + (L & 1); u.pn = (L >> 1) & 3; u.ko = (L >> 3) * 256; return true; }
    __device__ __forceinline__ void a_ready(const pg8::Unit&) const {}
    __device__ __forceinline__ void done(const pg8::Unit&) const {}
};
struct EpiPartial {
    static constexpr bool PERM = true, AFTER_DRAIN = false;
    float* PB;
    __device__ __forceinline__ void operator()(const f32x4 (&acc)[2][2][4][2], const pg8::Unit& u, int wr, int wc, int fr, int fq) const {
        float* base = PB + (size_t)(u.ko >> 8) * MC * D;
#pragma unroll
        for (int bj = 0; bj < 2; ++bj) { const int col = u.pn * 256 + bj * 128 + wc * 32 + fq * 8;
#pragma unroll
            for (int ai = 0; ai < 2; ++ai)
#pragma unroll
                for (int m = 0; m < 4; ++m) { const int row = u.pm * 256 + ai * 128 + wr * 64 + m * 16 + fr - ML; float* o = base + (size_t)row * D + col;
                    *(f32x4*)o = acc[ai][bj][m][0]; *(f32x4*)(o + 4) = acc[ai][bj][m][1]; }
        }
    }
};
struct CtxKvOrder {
    int G, c;
    __device__ bool next(int i, pg8::Unit& u) const { const int L = i * G + c; if (L >= 16) return false; u.pm = 64 + (L & 1); u.pn = 1 + ((L >> 1) & 1); u.ko = (L >> 2) * 256; return true; }
    __device__ __forceinline__ void a_ready(const pg8::Unit&) const {}
    __device__ __forceinline__ void done(const pg8::Unit&) const {}
};
struct EpiPartialKV {
    static constexpr bool PERM = true, AFTER_DRAIN = false;
    float* PB2;
    __device__ __forceinline__ void operator()(const f32x4 (&acc)[2][2][4][2], const pg8::Unit& u, int wr, int wc, int fr, int fq) const {
        float* base = PB2 + (size_t)(u.ko >> 8) * MC * 512;
#pragma unroll
        for (int bj = 0; bj < 2; ++bj) { const int col = (u.pn - 1) * 256 + bj * 128 + wc * 32 + fq * 8;
#pragma unroll
            for (int ai = 0; ai < 2; ++ai)
#pragma unroll
                for (int m = 0; m < 4; ++m) { const int row = u.pm * 256 + ai * 128 + wr * 64 + m * 16 + fr - ML; float* o = base + (size_t)row * 512 + col;
                    *(f32x4*)o = acc[ai][bj][m][0]; *(f32x4*)(o + 4) = acc[ai][bj][m][1]; }
        }
    }
};
struct EpiSwiglu {
    static constexpr bool PERM = true, AFTER_DRAIN = false;
    bf16_t* ACT;
    __device__ __forceinline__ void operator()(const f32x4 (&acc)[2][2][4][2], const pg8::Unit& u, int wr, int wc, int fr, int fq) const {
        const int col = u.pn * 128 + wc * 32 + fq * 8;
#pragma unroll
        for (int ai = 0; ai < 2; ++ai)
#pragma unroll
            for (int m = 0; m < 4; ++m) { const int row = u.pm * 256 + ai * 128 + wr * 64 + m * 16 + fr;
                const f32x4 a0 = acc[ai][0][m][0], a1 = acc[ai][0][m][1], b0 = acc[ai][1][m][0], b1 = acc[ai][1][m][1];
                float r[8];
#pragma unroll
                for (int i = 0; i < 4; ++i) { r[i] = siluf_(a0[i]) * b0[i]; r[4 + i] = siluf_(a1[i]) * b1[i]; }
                u32x4 w; w.x = cvt_pk_bf16(r[0], r[1]); w.y = cvt_pk_bf16(r[2], r[3]); w.z = cvt_pk_bf16(r[4], r[5]); w.w = cvt_pk_bf16(r[6], r[7]);
                *(u32x4*)(ACT + (size_t)row * DFF + col) = w; }
    }
};

constexpr int NW = 8, QBLK = 32, KVBLK = 64;
constexpr float ATT_THR = 8.f;
constexpr float THRL = ATT_THR * 1.4426950408889634f;
constexpr int SHM_V = KVBLK * DV * 2  , SHM_K = KVBLK * 256  ;
#define KSWZ(row, colB) ((row) * 256 + ((colB) ^ (((row) & 7) << 4)))
#define SBAR() __builtin_amdgcn_sched_barrier(0)
__device__ __forceinline__ int crow(int r, int hi) { return (r & 3) + 8 * (r >> 2) + 4 * hi; }
template <bool FIRST>
__device__ __forceinline__ void partialSM(f32x16& p0, f32x16& p1, float& m_reg, float& alpha, f32x16& negm) {
    float pmax = p0[0];
#pragma unroll
    for (int r = 1; r < 16; ++r) pmax = fmaxf(pmax, p0[r]);
#pragma unroll
    for (int r = 0; r < 16; ++r) pmax = fmaxf(pmax, p1[r]);
    { auto rr = __builtin_amdgcn_permlane32_swap(__float_as_uint(pmax), __float_as_uint(pmax), false, false);
      pmax = fmaxf(__uint_as_float(rr[0]), __uint_as_float(rr[1])); }
    if (!FIRST && __builtin_expect(__all(pmax <= THRL), 1)) { alpha = 1.f; }
    else { const float d = FIRST ? pmax : fmaxf(pmax, 0.f); alpha = FIRST ? 1.f : __builtin_amdgcn_exp2f(-d); m_reg += d;
#pragma unroll
        for (int r = 0; r < 16; ++r) { p0[r] -= d; p1[r] -= d; }
#pragma unroll
        for (int r = 0; r < 16; ++r) negm[r] = -m_reg; }
#pragma unroll
    for (int r = 0; r < 16; ++r) p0[r] = __builtin_amdgcn_exp2f(p0[r]);
}
__device__ __forceinline__ void finishSM(f32x16& p0, f32x16& p1, float alpha, float& l_reg, bf16x8& pa0, bf16x8& pa1, bf16x8& pa2, bf16x8& pa3) {
#pragma unroll
    for (int r = 0; r < 16; ++r) p1[r] = __builtin_amdgcn_exp2f(p1[r]);
    float ps = 0;
#pragma unroll
    for (int r = 0; r < 16; ++r) ps += p0[r];
#pragma unroll
    for (int r = 0; r < 16; ++r) ps += p1[r];
    { auto rr = __builtin_amdgcn_permlane32_swap(__float_as_uint(ps), __float_as_uint(ps), false, false);
      ps = __uint_as_float(rr[0]) + __uint_as_float(rr[1]); }
    l_reg = l_reg * alpha + ps;
#define PK4(P, BASE, OUT) do { unsigned a0 = cvt_pk_bf16(P[BASE + 0], P[BASE + 1]), a1 = cvt_pk_bf16(P[BASE + 2], P[BASE + 3]);   \
    unsigned b0 = cvt_pk_bf16(P[BASE + 4], P[BASE + 5]), b1 = cvt_pk_bf16(P[BASE + 6], P[BASE + 7]);                              \
    auto r0 = __builtin_amdgcn_permlane32_swap(a0, b0, false, false); auto r1 = __builtin_amdgcn_permlane32_swap(a1, b1, false, false); \
    u32x4 w = {r0[0], r1[0], r0[1], r1[1]}; OUT = *reinterpret_cast<bf16x8*>(&w); } while (0)
    PK4(p0, 0, pa0); PK4(p0, 8, pa1); PK4(p1, 0, pa2); PK4(p1, 8, pa3);
#undef PK4
}
__device__ __forceinline__ void qkt(f32x16& p0, f32x16& p1, const char* Ks, const bf16x8* qr, const f32x16& negm, int r32, int hi) {
#define KF(d0, half) (*reinterpret_cast<const bf16x8*>(Ks + KSWZ((half) * 32 + r32, ((d0) * 16 + hi * 8) * 2)))
    bf16x8 a0 = KF(0, 0), a1 = KF(0, 1), b0 = KF(1, 0), b1 = KF(1, 1);
    SBAR();
    p0 = __builtin_amdgcn_mfma_f32_32x32x16_bf16(a0, qr[0], negm, 0, 0, 0); p1 = __builtin_amdgcn_mfma_f32_32x32x16_bf16(a1, qr[0], negm, 0, 0, 0);
    a0 = KF(2, 0); a1 = KF(2, 1);
    p0 = __builtin_amdgcn_mfma_f32_32x32x16_bf16(b0, qr[1], p0, 0, 0, 0);   p1 = __builtin_amdgcn_mfma_f32_32x32x16_bf16(b1, qr[1], p1, 0, 0, 0);
    b0 = KF(3, 0); b1 = KF(3, 1);
    p0 = __builtin_amdgcn_mfma_f32_32x32x16_bf16(a0, qr[2], p0, 0, 0, 0);   p1 = __builtin_amdgcn_mfma_f32_32x32x16_bf16(a1, qr[2], p1, 0, 0, 0);
    a0 = KF(4, 0); a1 = KF(4, 1);
    p0 = __builtin_amdgcn_mfma_f32_32x32x16_bf16(b0, qr[3], p0, 0, 0, 0);   p1 = __builtin_amdgcn_mfma_f32_32x32x16_bf16(b1, qr[3], p1, 0, 0, 0);
    b0 = KF(5, 0); b1 = KF(5, 1);
    p0 = __builtin_amdgcn_mfma_f32_32x32x16_bf16(a0, qr[4], p0, 0, 0, 0);   p1 = __builtin_amdgcn_mfma_f32_32x32x16_bf16(a1, qr[4], p1, 0, 0, 0);
    p0 = __builtin_amdgcn_mfma_f32_32x32x16_bf16(b0, qr[5], p0, 0, 0, 0);   p1 = __builtin_amdgcn_mfma_f32_32x32x16_bf16(b1, qr[5], p1, 0, 0, 0);
#undef KF
}
__device__ __forceinline__ int v_st(int k, int c) { const int kk = (k & ~0xC) | ((k & 4) << 1) | ((k & 8) >> 1); return ((kk >> 3) * 2 + (c >> 5)) * 512 + ((kk & 7) * 32 + (c & 31)) * 2; }
__device__ __forceinline__ int v_rd_base(int lane) { return ((lane & 3) << 3) | (((lane >> 2) & 3) << 6) | (((lane >> 4) & 1) << 5) | (((lane >> 5) & 1) << 8); }
constexpr int v_rd_off(int d0, int ks, int half) { return d0 * 512 + ks * 2048 + half * 1024; }
template <int OFF> __device__ __forceinline__ s16x4 tr_read(int vb) {
    s16x4 r; asm volatile("ds_read_b64_tr_b16 %0, %1 offset:%2" : "=&v"(r) : "v"(vb), "i"(OFF) : "memory"); return r;
}
template <int D0> __device__ __forceinline__ void pv_one(f32x16& od, int vb, bf16x8 pa0, bf16x8 pa1, bf16x8 pa2, bf16x8 pa3) {
    const s16x4 l0 = tr_read<v_rd_off(D0, 0, 0)>(vb), h0 = tr_read<v_rd_off(D0, 0, 1)>(vb), l1 = tr_read<v_rd_off(D0, 1, 0)>(vb), h1 = tr_read<v_rd_off(D0, 1, 1)>(vb);
    const s16x4 l2 = tr_read<v_rd_off(D0, 2, 0)>(vb), h2 = tr_read<v_rd_off(D0, 2, 1)>(vb), l3 = tr_read<v_rd_off(D0, 3, 0)>(vb), h3 = tr_read<v_rd_off(D0, 3, 1)>(vb);
    asm volatile("s_waitcnt lgkmcnt(0)" ::: "memory"); SBAR();
#define PK(L, H) (bf16x8){L[0], L[1], L[2], L[3], H[0], H[1], H[2], H[3]}
    od = __builtin_amdgcn_mfma_f32_32x32x16_bf16(pa0, PK(l0, h0), od, 0, 0, 0);
    od = __builtin_amdgcn_mfma_f32_32x32x16_bf16(pa1, PK(l1, h1), od, 0, 0, 0);
    od = __builtin_amdgcn_mfma_f32_32x32x16_bf16(pa2, PK(l2, h2), od, 0, 0, 0);
    od = __builtin_amdgcn_mfma_f32_32x32x16_bf16(pa3, PK(l3, h3), od, 0, 0, 0);
#undef PK
}
__device__ __forceinline__ void pv_d0(f32x16* o, int vb, bf16x8 pa0, bf16x8 pa1, bf16x8 pa2, bf16x8 pa3) {
    pv_one<0>(o[0], vb, pa0, pa1, pa2, pa3); pv_one<1>(o[1], vb, pa0, pa1, pa2, pa3);
}
__device__ __forceinline__ void attn_unit(const bf16_t* __restrict__ Qb, const bf16_t* __restrict__ Kh, const bf16_t* __restrict__ Vh, bf16_t* __restrict__ Ob, int nkeys, char* lds) {
    const int tid = tid_fresh(), wid = tid >> 6, lane = tid & 63, r32 = lane & 31, hi = lane >> 5;
    char* V_lds = lds; char* K_lds = lds + 3 * SHM_V;
    float* ws = (float*)(lds + 3 * SHM_V + 3 * SHM_K) + wid * 64; float* li_l = ws; float* al_l = ws + 32;
    float m_reg = 0.f, l_reg = 0; f32x16 o[2] = {}; bf16x8 qr[6]; f32x16 negm = f32x16{};
    const bf16_t* Qw = Qb + (size_t)(wid * QBLK + r32) * DQK + hi * 8;
#pragma unroll
    for (int d0 = 0; d0 < 6; ++d0) qr[d0] = *reinterpret_cast<const bf16x8*>(Qw + d0 * 16);
    const int kid0 = tid, kid1 = 512 + tid; const bool k1 = tid < 256;
    const int kst0 = KSWZ(kid0 / 12, (kid0 % 12) * 16), kst1 = KSWZ(kid1 / 12, (kid1 % 12) * 16);
    const int vst0 = v_st(tid >> 3, (tid & 7) * 8);
    const int vb0 = (int)(uintptr_t)V_lds + v_rd_base(lane);
    const char* Kg = (const char*)Kh; const char* Vg = (const char*)Vh;
    bf16x8 sA_v, sA_k0, sA_k1, sB_v, sB_k0, sB_k1;
    sA_k1 = bf16x8{}; sB_k1 = bf16x8{};
#define SLOAD_A(kt) do { sA_v = *(const bf16x8*)(Vg + (size_t)(kt) * (KVBLK * DV * 2) + tid * 16); sA_k0 = *(const bf16x8*)(Kg + (size_t)(kt) * (KVBLK * DQK * 2) + kid0 * 16); \
    if (k1) sA_k1 = *(const bf16x8*)(Kg + (size_t)(kt) * (KVBLK * DQK * 2) + kid1 * 16); } while (0)
#define SLOAD_B(kt) do { sB_v = *(const bf16x8*)(Vg + (size_t)(kt) * (KVBLK * DV * 2) + tid * 16); sB_k0 = *(const bf16x8*)(Kg + (size_t)(kt) * (KVBLK * DQK * 2) + kid0 * 16); \
    if (k1) sB_k1 = *(const bf16x8*)(Kg + (size_t)(kt) * (KVBLK * DQK * 2) + kid1 * 16); } while (0)
#define SWRITE_A(b) do { *(bf16x8*)(V_lds + (b) * SHM_V + vst0) = sA_v; *(bf16x8*)(K_lds + (b) * SHM_K + kst0) = sA_k0; if (k1) *(bf16x8*)(K_lds + (b) * SHM_K + kst1) = sA_k1; } while (0)
#define SWRITE_B(b) do { *(bf16x8*)(V_lds + (b) * SHM_V + vst0) = sB_v; *(bf16x8*)(K_lds + (b) * SHM_K + kst0) = sB_k0; if (k1) *(bf16x8*)(K_lds + (b) * SHM_K + kst1) = sB_k1; } while (0)
#define RESC(a) do { if (__any((a) < 1.f)) { if (hi == 0) al_l[r32] = (a); asm volatile("s_waitcnt lgkmcnt(0)" ::: "memory"); \
    _Pragma("unroll") for (int d = 0; d < 2; ++d) _Pragma("unroll") for (int r = 0; r < 16; ++r) o[d][r] *= al_l[crow(r, hi)]; } } while (0)
    f32x16 pA0, pA1, pB0, pB1; float alA, alB; bf16x8 pa0, pa1, pa2, pa3; const int NT = nkeys / KVBLK;
    int kcur = 0, kprev = 0, knext = 1;
#define ROT3() do { kprev = kcur; kcur = knext; knext = (knext == 2) ? 0 : knext + 1; } while (0)
    SLOAD_A(0); asm volatile("s_waitcnt vmcnt(0)" ::: "memory"); SWRITE_A(0); __syncthreads();
    qkt(pA0, pA1, K_lds, qr, negm, r32, hi); partialSM<true>(pA0, pA1, m_reg, alA, negm);
    SLOAD_B(1); if (2 < NT) SLOAD_A(2);
    SWRITE_B(1); __syncthreads();
    kcur = 1; kprev = 0; knext = 2;
    for (int j = 1; j + 1 < NT; j += 2) {
        SBAR(); qkt(pB0, pB1, K_lds + kcur * SHM_K, qr, negm, r32, hi);
        finishSM(pA0, pA1, alA, l_reg, pa0, pa1, pa2, pa3); SBAR();
        SLOAD_B(j + 2); SBAR();
        pv_d0(o, vb0 + kprev * SHM_V, pa0, pa1, pa2, pa3); partialSM<false>(pB0, pB1, m_reg, alB, negm);
        SWRITE_A(knext);
        RESC(alB); __syncthreads(); ROT3();
        SBAR(); qkt(pA0, pA1, K_lds + kcur * SHM_K, qr, negm, r32, hi);
        finishSM(pB0, pB1, alB, l_reg, pa0, pa1, pa2, pa3); SBAR();
        if (j + 3 < NT) SLOAD_A(j + 3); SBAR();
        pv_d0(o, vb0 + kprev * SHM_V, pa0, pa1, pa2, pa3); partialSM<false>(pA0, pA1, m_reg, alA, negm);
        SWRITE_B(knext);
        RESC(alA); __syncthreads(); ROT3();
    }
    SBAR(); qkt(pB0, pB1, K_lds + kcur * SHM_K, qr, negm, r32, hi);
    finishSM(pA0, pA1, alA, l_reg, pa0, pa1, pa2, pa3); SBAR();
    pv_d0(o, vb0 + kprev * SHM_V, pa0, pa1, pa2, pa3); partialSM<false>(pB0, pB1, m_reg, alB, negm);
    RESC(alB);
    finishSM(pB0, pB1, alB, l_reg, pa0, pa1, pa2, pa3); SBAR();
    pv_d0(o, vb0 + kcur * SHM_V, pa0, pa1, pa2, pa3);
#undef ROT3
    if (hi == 0) li_l[r32] = l_reg; asm volatile("s_waitcnt lgkmcnt(0)" ::: "memory");
    float rli[16];
#pragma unroll
    for (int r = 0; r < 16; ++r) rli[r] = __builtin_amdgcn_rcpf(li_l[crow(r, hi)]);
    bf16_t* Ow = Ob + (size_t)(wid * QBLK) * 512;
#pragma unroll
    for (int r = 0; r < 16; ++r) { const int orow = crow(r, hi);
#pragma unroll
        for (int d0 = 0; d0 < 2; ++d0) Ow[(size_t)orow * 512 + d0 * 32 + r32] = (bf16_t)(cvt_pk_bf16(o[d0][r] * rli[r], 0.f) & 0xffffu); }
    __syncthreads();
#undef SLOAD_A
#undef SLOAD_B
#undef SWRITE_A
#undef SWRITE_B
#undef RESC
}

__device__ __forceinline__ void phase_mod(const Params& p, LAS unsigned char* lds) {
    float* mod = (float*)(p.ws + WS_MOD);
    const int tid = tid_fresh();
    if (blockIdx.x == 0) { float* rope = (float*)(p.ws + WS_ROPE);
        for (int i = tid; i < 1024; i += 512) { const int pos = i >> 3, f = i & 7; const float inv = powf(10000.f, -(float)(2 * f) / 16.f); const float ang = (float)pos * inv;
            rope[i] = cosf(ang); rope[1024 + i] = sinf(ang); } }
    LAS float* red = (LAS float*)lds;
    const int cq = tid & 127, ks = tid >> 7;
    for (int it = blockIdx.x; it < 2 * 8 * 12; it += gridDim.x) {
        const int l = it / 96, r = it % 96, kc = r / 12, nb = r % 12; const int n = nb * 512 + cq * 4; const int kbase = kc * 128 + ks * 32;
        const float* w = p.w_mod + ((size_t)l * D + kbase) * NMOD + n;
        f32x4 wv[32];
#pragma unroll
        for (int k = 0; k < 32; ++k) wv[k] = *(const f32x4*)(w + (size_t)k * NMOD);
        f32x4 a0 = {0.f, 0.f, 0.f, 0.f}, a1 = a0, a2 = a0;
#pragma unroll
        for (int k = 0; k < 32; ++k) { const int kk = kbase + k; const float c0 = p.c[kk], c1 = p.c[D + kk], c2 = p.c_ctx[kk];
            a0 += wv[k] * (c0 / (1.f + expf(-c0))); a1 += wv[k] * (c1 / (1.f + expf(-c1))); a2 += wv[k] * (c2 / (1.f + expf(-c2))); }
        __syncthreads();
        if (ks > 0) { LAS float* dst = red + ((ks - 1) * 128 + cq) * 12;
            *(LAS f32x4*)dst = a0; *(LAS f32x4*)(dst + 4) = a1; *(LAS f32x4*)(dst + 8) = a2; }
        __syncthreads();
        if (ks == 0) {
#pragma unroll
            for (int q = 0; q < 3; ++q) { const LAS float* src = red + (q * 128 + cq) * 12; a0 += *(const LAS f32x4*)src; a1 += *(const LAS f32x4*)(src + 4); a2 += *(const LAS f32x4*)(src + 8); }
            if (kc == 0) { const f32x4 bv = *(const f32x4*)(p.b_mod + l * NMOD + n); a0 += bv; a1 += bv; a2 += bv; }
#pragma unroll
            for (int i = 0; i < 4; ++i) { atomicAdd(mod + (l * 3 + 0) * NMOD + n + i, a0[i]); atomicAdd(mod + (l * 3 + 1) * NMOD + n + i, a1[i]); atomicAdd(mod + (l * 3 + 2) * NMOD + n + i, a2[i]); }
        }
    }
}
struct TItem { const float* W; bf16_t* WT; const float* ks; int K, N, k0, n0, drow; };
__device__ __forceinline__ TItem wconv_decode(const Params& p, int l, int it) {
    unsigned char* wb = p.ws + WS_W;
    constexpr int I_IN = 16 * 157, I_Q = 6 * 24, I_KV = 4 * 32, I_MO = 8 * 32, I_CO = 4 * 32, I_SO = 4 * 32, I_O = 16 * 32, I_1 = 16 * 88, I_3 = 16 * 88;
    TItem t; t.ks = nullptr; int r = it, nblk;
    if (r < I_IN) { t.W = p.w_in + (size_t)l * D * INC; t.WT = (bf16_t*)(wb + W_IN); t.K = D; t.N = INC; nblk = 157; }
    else if ((r -= I_IN) < I_Q) { t.W = p.w_q_b + (size_t)l * QLORA * 768; t.WT = (bf16_t*)(wb + W_Q); t.K = QLORA; t.N = 768; nblk = 24; t.ks = p.q_g + l * QLORA; }
    else if ((r -= I_Q) < I_KV) { t.W = p.w_kv_b + (size_t)l * KVLORA * 1024; t.WT = (bf16_t*)(wb + W_KV); t.K = KVLORA; t.N = 1024; nblk = 32; t.ks = p.kv_g + l * KVLORA; }
    else if ((r -= I_KV) < I_MO) { t.W = p.w_mla_o + (size_t)l * 512 * 1024; t.WT = (bf16_t*)(wb + W_MO); t.K = 512; t.N = 1024; nblk = 32; }
    else if ((r -= I_MO) < I_CO) { t.W = p.w_conv_o + (size_t)l * 256 * 1024; t.WT = (bf16_t*)(wb + W_CO); t.K = 256; t.N = 1024; nblk = 32; }
    else if ((r -= I_CO) < I_SO) { t.W = p.w_sc_o + (size_t)l * 256 * 1024; t.WT = (bf16_t*)(wb + W_SO); t.K = 256; t.N = 1024; nblk = 32; }
    else if ((r -= I_SO) < I_O) { t.W = p.w_o + (size_t)l * D * D; t.WT = (bf16_t*)(wb + W_O); t.K = D; t.N = D; nblk = 32; }
    else if ((r -= I_O) < I_1) { t.W = p.w_ff1 + (size_t)l * D * DFF; t.WT = (bf16_t*)(wb + W_13); t.K = D; t.N = DFF; nblk = 88; }
    else if ((r -= I_1) < I_3) { t.W = p.w_ff3 + (size_t)l * D * DFF; t.WT = (bf16_t*)(wb + W_13); t.K = D; t.N = DFF; nblk = 88; r += 1 << 20; }
    else { r -= I_3; t.W = p.w_ff2 + (size_t)l * DFF * D; t.WT = (bf16_t*)(wb + W_2); t.K = DFF; t.N = D; nblk = 32; }
    const bool is3 = r >= (1 << 20); r &= (1 << 20) - 1;
    const int kb = r / nblk, nb = r - kb * nblk; t.k0 = kb * 64; t.n0 = nb * 32; t.drow = t.n0;
    if (it < I_IN) t.drow = t.n0 < 1952 ? t.n0 : t.n0 + 96;
    else if (nblk == 88) t.drow = (t.n0 >> 7) * 256 + (t.n0 & 127) + (is3 ? 128 : 0);
    return t;
}
__device__ __forceinline__ void wconv_load(const TItem& t, float (&tv)[32], int lane) {
    const float* src = t.W + (size_t)(t.k0 + (lane >> 5)) * t.N + t.n0 + (lane & 31);
#pragma unroll
    for (int i = 0; i < 32; ++i) tv[i] = src[(size_t)(2 * i) * t.N];
}
__device__ __forceinline__ void wconv_finish(const TItem& t, const float (&tv)[32], LAS float* scr, int lane) {
#pragma unroll
    for (int i = 0; i < 32; ++i) { const int kk = 2 * i + (lane >> 5); float v = tv[i]; if (t.ks) v *= t.ks[t.k0 + kk]; scr[kk * 33 + (lane & 31)] = v; }
    asm volatile("s_waitcnt lgkmcnt(0)" ::: "memory");
    const int c = lane & 7;
#pragma unroll
    for (int j = 0; j < 4; ++j) { const int n = (lane >> 3) + 8 * j; const LAS float* sp = scr + (8 * c) * 33 + n;
        u32x4 o; o.x = cvt_pk_bf16(sp[0 * 33], sp[1 * 33]); o.y = cvt_pk_bf16(sp[2 * 33], sp[3 * 33]); o.z = cvt_pk_bf16(sp[4 * 33], sp[5 * 33]); o.w = cvt_pk_bf16(sp[6 * 33], sp[7 * 33]);
        *(u32x4*)(t.WT + (size_t)(t.drow + n) * t.K + t.k0 + 8 * c) = o; }
    asm volatile("s_waitcnt lgkmcnt(0)" ::: "memory");
}
__device__ __forceinline__ void phase_wconv(const Params& p, int l, LAS unsigned char* lds) {
    const int tid = tid_fresh(), lane = tid & 63, wave = tid >> 6;
    LAS float* scr = (LAS float*)(lds + wave * 16384);
    const int gw = blockIdx.x * 8 + wave, NGW = gridDim.x * 8;
    constexpr int NITEMS = 16 * 157 + 6 * 24 + 4 * 32 + 8 * 32 + 4 * 32 + 4 * 32 + 16 * 32 + 16 * 88 + 16 * 88 + 44 * 32;
#pragma unroll 1
    for (int it = gw; it < NITEMS; it += 2 * NGW) {
        const bool two = it + NGW < NITEMS;
        const TItem t0 = wconv_decode(p, l, it); const TItem t1 = wconv_decode(p, l, two ? it + NGW : it);
        float v0[32], v1[32];
        wconv_load(t0, v0, lane); if (two) wconv_load(t1, v1, lane);
        wconv_finish(t0, v0, scr, lane); if (two) wconv_finish(t1, v1, scr, lane);
    }
    bf16_t* WinT = (bf16_t*)(p.ws + WS_W + W_IN);
    for (int i = blockIdx.x * 512 + tid; i < 12288; i += gridDim.x * 512) *(u32x4*)((unsigned char*)(WinT + (size_t)1952 * D) + (size_t)i * 16) = (u32x4){0u, 0u, 0u, 0u};
}
template <int MODE  , int R>
__device__ __forceinline__ void norm_rows(const Params& p, const float* xL, const float* xC, const float* gain, const float* modl, int jshift, int row0, int lane, float* xc_copy, const float* pb, int nsplit, const float* pg) {
    bf16_t* H = (bf16_t*)(p.ws + WS_H);
    f32x4 v[R][4];
#pragma unroll
    for (int r = 0; r < R; ++r) { const int row = row0 + r; const float* xr = row < ML ? xL + (size_t)row * D : xC + (size_t)(row - ML) * D;
#pragma unroll
        for (int j = 0; j < 4; ++j) v[r][j] = *(const f32x4*)(xr + 4 * lane + 256 * j); }
#pragma unroll
    for (int r = 0; r < R; ++r) { const int row = row0 + r; float ss = 0.f;
        if (MODE == 0 && R == 1 && pb && row >= ML) {
#pragma unroll
            for (int j = 0; j < 4; ++j) { const int c = 4 * lane + 256 * j; f32x4 a = *(const f32x4*)(pb + (size_t)(row - ML) * D + c);
                for (int sp = 1; sp < nsplit; ++sp) a += *(const f32x4*)(pb + ((size_t)sp * MC + (row - ML)) * D + c);
                v[r][j] += *(const f32x4*)(pg + c) * a; } }
#pragma unroll
        for (int j = 0; j < 4; ++j) ss += (v[r][j].x * v[r][j].x + v[r][j].y * v[r][j].y) + (v[r][j].z * v[r][j].z + v[r][j].w * v[r][j].w);
        const float rstd = 1.f / sqrtf(wave_sum(ss) * (1.f / D) + EPS);
        if (MODE == 0) {
            if (R == 1 && xc_copy && row >= ML) {
#pragma unroll
                for (int j = 0; j < 4; ++j) *(f32x4*)(xc_copy + (size_t)(row - ML) * D + 4 * lane + 256 * j) = v[r][j]; }
            const int grp = row < SEQ ? 0 : (row < ML ? 1 : 2); const float* sh = modl + grp * NMOD + jshift * D; const float* sc = sh + D;
#pragma unroll
            for (int j = 0; j < 4; ++j) { const int c = 4 * lane + 256 * j; const f32x4 g = *(const f32x4*)(gain + c), sv = *(const f32x4*)(sc + c), b = *(const f32x4*)(sh + c);
                const f32x4 y = v[r][j] * rstd * g * (sv + 1.f) + b;
                u32x2 w; w.x = cvt_pk_bf16(y.x, y.y); w.y = cvt_pk_bf16(y.z, y.w); *(u32x2*)(H + (size_t)row * D + c) = w; }
        } else {
#pragma unroll
            for (int j = 0; j < 4; ++j) { const int c = 4 * lane + 256 * j; const f32x4 g = *(const f32x4*)(gain + c); *(f32x4*)(p.out + (size_t)row * D + c) = v[r][j] * rstd * g; }
        }
    }
}
template <int MODE>
__device__ __forceinline__ void phase_norm(const Params& p, const float* xL, const float* xC, const float* gain, const float* modl, int jshift, int nrows, float* xc_copy = nullptr, const float* pb = nullptr, int nsplit = 0, const float* pg = nullptr) {
    const int tid = tid_fresh(), lane = tid & 63, wave = tid >> 6; const int gw = blockIdx.x * 8 + wave, NGW = gridDim.x * 8;
    int ngrp = ((nrows >> 3) / NGW) * NGW; if (ngrp > ML / 8) ngrp = ML / 8;
    for (int g = gw; g < ngrp; g += NGW) norm_rows<MODE, 8>(p, xL, xC, gain, modl, jshift, g * 8, lane, xc_copy, pb, nsplit, pg);
    for (int r = ngrp * 8 + gw; r < nrows; r += NGW) norm_rows<MODE, 1>(p, xL, xC, gain, modl, jshift, r, lane, xc_copy, pb, nsplit, pg);
}
__device__ __forceinline__ void phase_prep(const Params& p, int l, LAS unsigned char* lds, const float* kvslab) {
    const int tid = tid_fresh(), lane = tid & 63, wave = tid >> 6;
    const bf16_t* P1 = (const bf16_t*)(p.ws + WS_P1);
    bf16_t* QN = (bf16_t*)(p.ws + WS_QN); bf16_t* CKV = (bf16_t*)(p.ws + WS_CKV); bf16_t* CACT = (bf16_t*)(p.ws + WS_CACT); bf16_t* SACT = (bf16_t*)(p.ws + WS_SACT);
    bf16_t* KR = (bf16_t*)(p.ws + WS_KR); const float* rope = (const float*)(p.ws + WS_ROPE);
    LAS float* Gs = (LAS float*)lds;
    LAS float* Ss = (LAS float*)(lds + 62 * 1024);
    LAS float* Us = (LAS float*)(lds + 96 * 1024);
    const int c = tid & 255, tsub = tid >> 8;
    float dw[31];
#pragma unroll
    for (int w = 0; w < 31; ++w) dw[w] = p.conv_dw[((size_t)l * 31 + w) * 256 + c];
    const float dwb = p.conv_dw_b[l * 256 + c];
    const float s0 = p.sc_dw[((size_t)l * 3 + 0) * 256 + c], s1 = p.sc_dw[((size_t)l * 3 + 1) * 256 + c], s2 = p.sc_dw[((size_t)l * 3 + 2) * 256 + c];
    const float* lng = p.conv_ln_g + l * 256; const float* lnb = p.conv_ln_b + l * 256;
    constexpr int NCH = ML / 32 + MC / 8;
    u32x4 ga[4], gg[4], sa[3], sg[3];
#define PREP_GEOM(ch_) const int T = (ch_) < ML / 32 ? 32 : 8; const int row0 = (ch_) < ML / 32 ? (ch_) * 32 : ML + ((ch_) - ML / 32) * 8; const bool lat = row0 < ML; \
        const int seqbase = lat ? (row0 & ~(SEQ - 1)) : ML + ((row0 - ML) & ~(CTX - 1)); const int L = lat ? SEQ : CTX; const int t0 = row0 - seqbase;
#define PREP_LOAD(ch_) do { PREP_GEOM(ch_) \
        _Pragma("unroll") for (int k = 0; k < 4; ++k) { const int it = tid + 512 * k; const int r = it >> 5, o8 = (it & 31) * 8; const int t = t0 - 15 + r; \
            if (it < (T + 30) * 32 && t >= 0 && t < L) { const bf16_t* src = P1 + (size_t)(seqbase + t) * NP1; ga[k] = *(const u32x4*)(src + 672 + o8); gg[k] = *(const u32x4*)(src + 928 + o8); } } } while (0)
    if ((int)blockIdx.x < NCH) PREP_LOAD((int)blockIdx.x);
    for (int ch = blockIdx.x; ch < NCH; ch += gridDim.x) {
        PREP_GEOM(ch)
        __syncthreads();
#pragma unroll
        for (int k = 0; k < 3; ++k) { const int it = tid + 512 * k; const int r = it >> 5, o8 = (it & 31) * 8; const int t = t0 - 1 + r;
            if (it < (T + 2) * 32 && t >= 0 && t < L) { const bf16_t* src = P1 + (size_t)(seqbase + t) * NP1; sa[k] = *(const u32x4*)(src + 1440 + o8); sg[k] = *(const u32x4*)(src + 1696 + o8); } }
#pragma unroll
        for (int k = 0; k < 4; ++k) { const int it = tid + 512 * k; const int r = it >> 5, o8 = (it & 31) * 8; const int t = t0 - 15 + r;
            if (it < (T + 30) * 32) { LAS float* dst = Gs + r * 256 + o8;
                if (t >= 0 && t < L) { const u32x4 a = ga[k], g = gg[k];
                    dst[0] = bflo(a.x) * sigmoidf_(bflo(g.x)); dst[1] = bfhi(a.x) * sigmoidf_(bfhi(g.x)); dst[2] = bflo(a.y) * sigmoidf_(bflo(g.y)); dst[3] = bfhi(a.y) * sigmoidf_(bfhi(g.y));
                    dst[4] = bflo(a.z) * sigmoidf_(bflo(g.z)); dst[5] = bfhi(a.z) * sigmoidf_(bfhi(g.z)); dst[6] = bflo(a.w) * sigmoidf_(bflo(g.w)); dst[7] = bfhi(a.w) * sigmoidf_(bfhi(g.w));
                } else {
#pragma unroll
                    for (int i = 0; i < 8; ++i) dst[i] = 0.f; } } }
#pragma unroll
        for (int k = 0; k < 3; ++k) { const int it = tid + 512 * k; const int r = it >> 5, o8 = (it & 31) * 8; const int t = t0 - 1 + r;
            if (it < (T + 2) * 32) { LAS float* dst = Ss + r * 256 + o8;
                if (t >= 0 && t < L) { const u32x4 a = sa[k], g = sg[k];
                    dst[0] = bflo(a.x) * bflo(g.x); dst[1] = bfhi(a.x) * bfhi(g.x); dst[2] = bflo(a.y) * bflo(g.y); dst[3] = bfhi(a.y) * bfhi(g.y);
                    dst[4] = bflo(a.z) * bflo(g.z); dst[5] = bfhi(a.z) * bfhi(g.z); dst[6] = bflo(a.w) * bflo(g.w); dst[7] = bfhi(a.w) * bfhi(g.w);
                } else {
#pragma unroll
                    for (int i = 0; i < 8; ++i) dst[i] = 0.f; } } }
        __syncthreads();
        if (ch + (int)gridDim.x < NCH) PREP_LOAD(ch + (int)gridDim.x);
        unsigned short bgv[16];
#pragma unroll
        for (int tt = 0; tt < 16; ++tt) if (tt * 2 < T) bgv[tt] = P1[(size_t)(row0 + tt * 2 + tsub) * NP1 + 1184 + c];
#pragma unroll
        for (int tt = 0; tt < 16; ++tt) if (tt * 2 < T) { const int tok = tt * 2 + tsub; float u = dwb;
#pragma unroll
            for (int w = 0; w < 31; ++w) u += dw[w] * Gs[(tok + w) * 256 + c];
            Us[tok * 256 + c] = u;
            const float sv = s0 * Ss[tok * 256 + c] + s1 * Ss[(tok + 1) * 256 + c] + s2 * Ss[(tok + 2) * 256 + c];
            const float bg = bf2f(bgv[tt]);
            SACT[(size_t)(row0 + tok) * 256 + c] = (bf16_t)(cvt_pk_bf16(bg * sv, 0.f) & 0xffffu); }
        __syncthreads();
#pragma unroll
        for (int q = 0; q < 4; ++q) if (q * 8 < T) { const int tok = wave + 8 * q; const int row = row0 + tok; const bf16_t* src = P1 + (size_t)row * NP1;
            { const f32x4 u = *(const LAS f32x4*)(Us + tok * 256 + 4 * lane); const float mu = wave_sum((u.x + u.y) + (u.z + u.w)) * (1.f / 256.f);
              const f32x4 d = u - mu; const float var = wave_sum((d.x * d.x + d.y * d.y) + (d.z * d.z + d.w * d.w)) * (1.f / 256.f); const float rstd = 1.f / sqrtf(var + EPS);
              const f32x4 g = *(const f32x4*)(lng + 4 * lane), b = *(const f32x4*)(lnb + 4 * lane); f32x4 y = d * rstd * g + b;
              y.x = siluf_(y.x); y.y = siluf_(y.y); y.z = siluf_(y.z); y.w = siluf_(y.w);
              u32x2 w; w.x = cvt_pk_bf16(y.x, y.y); w.y = cvt_pk_bf16(y.z, y.w); *(u32x2*)(CACT + (size_t)row * 256 + 4 * lane) = w; }
            { const u32x2 a = *(const u32x2*)(src + 4 * lane); const unsigned b2 = *(const unsigned*)(src + 256 + 2 * lane);
              const float x0 = bflo(a.x), x1 = bfhi(a.x), x2 = bflo(a.y), x3 = bfhi(a.y), x4 = bflo(b2), x5 = bfhi(b2);
              const float ss = wave_sum((x0 * x0 + x1 * x1) + (x2 * x2 + x3 * x3) + (x4 * x4 + x5 * x5)); const float rstd = 1.f / sqrtf(ss * (1.f / 384.f) + EPS);
              u32x2 w; w.x = cvt_pk_bf16(x0 * rstd, x1 * rstd); w.y = cvt_pk_bf16(x2 * rstd, x3 * rstd); *(u32x2*)(QN + (size_t)row * QLORA + 4 * lane) = w;
              *(unsigned*)(QN + (size_t)row * QLORA + 256 + 2 * lane) = cvt_pk_bf16(x4 * rstd, x5 * rstd); }
            { float x0, x1, x2, x3;
              if (q == 0 && kvslab && !lat) { f32x4 a4 = *(const f32x4*)(kvslab + (size_t)(row - ML) * 512 + 128 + 4 * lane);
#pragma unroll
                  for (int sp = 1; sp < 4; ++sp) a4 += *(const f32x4*)(kvslab + ((size_t)sp * MC + (row - ML)) * 512 + 128 + 4 * lane);
                  x0 = a4.x; x1 = a4.y; x2 = a4.z; x3 = a4.w; }
              else { const u32x2 a = *(const u32x2*)(src + 384 + 4 * lane); x0 = bflo(a.x); x1 = bfhi(a.x); x2 = bflo(a.y); x3 = bfhi(a.y); }
              const float ss = wave_sum((x0 * x0 + x1 * x1) + (x2 * x2 + x3 * x3)); const float rstd = 1.f / sqrtf(ss * (1.f / 256.f) + EPS);
              u32x2 w; w.x = cvt_pk_bf16(x0 * rstd, x1 * rstd); w.y = cvt_pk_bf16(x2 * rstd, x3 * rstd); *(u32x2*)(CKV + (size_t)row * 256 + 4 * lane) = w; }
            { int b, qi; row_to_bq(row, b, qi); const int j = lane & 31; float v;
              if (q == 0 && kvslab && !lat) { v = 0.f;
#pragma unroll
                  for (int sp = 0; sp < 4; ++sp) v += kvslab[((size_t)sp * MC + (row - ML)) * 512 + 384 + j]; }
              else v = bf2f(src[640 + j]);
              const float pv = __shfl_xor(v, 8);
              if (lat) { const int pos = (j >> 4) ? (qi & 63) : (qi >> 6); const int f = j & 7; const float cs = rope[pos * 8 + f], sn = rope[1024 + pos * 8 + f];
                  v = (j & 8) ? pv * sn + v * cs : v * cs - pv * sn; }
              const bf16_t o = (bf16_t)(cvt_pk_bf16(v, 0.f) & 0xffffu);
              if (lane < 32) KR[(size_t)row * 32 + j] = o; }
        }
    }
}

#undef PREP_GEOM
#undef PREP_LOAD
#define XB_TMO      128
#define XB_XCNT(j)  (256  + 64 * (j))
#define XB_XSUB(j)  (1280 + 64 * (j))
#define XB_XGEN(j)  (2304 + 64 * (j))
#define XB_TOP      3328
#define XB_TOPGEN   3392
#define XCD_BAR_WORDS 3456
#define XB_SPIN_CAP (1u << 18)

__device__ __forceinline__ unsigned xb_ld(unsigned* p)              { return __hip_atomic_load(p, __ATOMIC_RELAXED, __HIP_MEMORY_SCOPE_AGENT); }
__device__ __forceinline__ unsigned xb_add(unsigned* p, unsigned v) { return __hip_atomic_fetch_add(p, v, __ATOMIC_RELAXED, __HIP_MEMORY_SCOPE_AGENT); }
__device__ __forceinline__ unsigned xb_xcc_id() { return (unsigned)__builtin_amdgcn_s_getreg((3 << 11) | 20) & 0xFu; }
#define XB_SPIN(cond, bar) do { unsigned _sp = 0; while (cond) { __builtin_amdgcn_s_sleep(1); \
    if ((++_sp & 255u) == 0u) { if (xb_ld(&(bar)[XB_TMO])) break; if (_sp > XB_SPIN_CAP) { atomicAdd(&(bar)[XB_TMO], 1u); break; } } } } while (0)

struct XcdBarrier {
    unsigned* bar; unsigned x;
    volatile LAS unsigned* st;
};

__device__ __forceinline__ XcdBarrier xcd_barrier_post(unsigned* bar, volatile LAS unsigned* st) {
    XcdBarrier b; b.bar = bar; b.x = xb_xcc_id(); b.st = st;
    if (threadIdx.x == 0) (void)xb_add(&bar[XB_XCNT(b.x)], 1u);
    return b;
}
__device__ __forceinline__ void xcd_barrier_complete(unsigned* bar, unsigned x, unsigned& nloc, unsigned& nx) {
    const unsigned G = gridDim.x * gridDim.y * gridDim.z;
    unsigned sum, cnt, mine, sp = 0u;
    for (;;) {
        sum = 0u; cnt = 0u; mine = 0u;
#pragma unroll
        for (unsigned j = 0; j < 16; ++j) { const unsigned c = xb_ld(&bar[XB_XCNT(j)]); sum += c; cnt += (c > 0u) ? 1u : 0u; mine = (j == x) ? c : mine; }
        if (sum == G) break;
        __builtin_amdgcn_s_sleep(1);
        if ((++sp & 255u) == 0u) { if (xb_ld(&bar[XB_TMO])) break; if (sp > XB_SPIN_CAP) { atomicAdd(&bar[XB_TMO], 1u); break; } }
    }
    nloc = mine > 0u ? mine : 1u; nx = cnt > 0u ? cnt : 1u;
}

__device__ __forceinline__ void xcd_barrier(const XcdBarrier& b) {
    asm volatile("s_waitcnt vmcnt(0)" ::: "memory");
    __syncthreads();
    if (threadIdx.x == 0) {
        unsigned* bar = b.bar;
        __builtin_amdgcn_s_waitcnt(0);
        unsigned nloc = b.st[0], nx = b.st[1];
        if (nloc == 0u) { xcd_barrier_complete(bar, b.x, nloc, nx); b.st[0] = nloc; b.st[1] = nx; }
        const unsigned old = xb_add(&bar[XB_XSUB(b.x)], 1u);
        const unsigned gen = old / nloc;
        if (old + 1u == (gen + 1u) * nloc) {
            __builtin_amdgcn_fence(__ATOMIC_RELEASE, "agent");
            asm volatile("s_waitcnt vmcnt(0)" ::: "memory");
            const unsigned og = xb_add(&bar[XB_TOP], 1u);
            const unsigned tg = og / nx;
            if (og + 1u == (tg + 1u) * nx) xb_add(&bar[XB_TOPGEN], 1u);
            else XB_SPIN(xb_ld(&bar[XB_TOPGEN]) == tg, bar);
            __builtin_amdgcn_fence(__ATOMIC_ACQUIRE, "agent");
            xb_add(&bar[XB_XGEN(b.x)], 1u);
            asm volatile("s_waitcnt vmcnt(0)" ::: "memory");
        } else {
            XB_SPIN(xb_ld(&bar[XB_XGEN(b.x)]) == gen, bar);
            __builtin_amdgcn_fence(__ATOMIC_ACQUIRE, "agent");
            asm volatile("s_waitcnt vmcnt(0)" ::: "memory");
        }
    }
    __syncthreads();
}

__global__ void __launch_bounds__(512, 2) mega_fwd(Params p) {
    extern __shared__ __attribute__((aligned(16))) unsigned char lds_raw[];
    LAS unsigned char* lds = (LAS unsigned char*)lds_raw;
    cg::grid_group grid = cg::this_grid();
    { volatile LAS unsigned* st0 = (volatile LAS unsigned*)(lds + 131072 + 64); if (threadIdx.x < 2) st0[threadIdx.x] = 0u; __syncthreads(); }
    XcdBarrier xbar = xcd_barrier_post((unsigned*)(p.ws + WS_BAR), (volatile LAS unsigned*)(lds + 131072 + 64));
    unsigned char* ws = p.ws;
    const float* modall = (const float*)(ws + WS_MOD);
    float* XC = (float*)(ws + WS_XCTX);
    bf16_t* WinT = (bf16_t*)(ws + WS_W + W_IN); bf16_t* WqT = (bf16_t*)(ws + WS_W + W_Q); bf16_t* WkvT = (bf16_t*)(ws + WS_W + W_KV); bf16_t* WmoT = (bf16_t*)(ws + WS_W + W_MO);
    bf16_t* WcoT = (bf16_t*)(ws + WS_W + W_CO); bf16_t* WsoT = (bf16_t*)(ws + WS_W + W_SO); bf16_t* WoT = (bf16_t*)(ws + WS_W + W_O); bf16_t* W13T = (bf16_t*)(ws + WS_W + W_13); bf16_t* W2T = (bf16_t*)(ws + WS_W + W_2);
    bf16_t* GATES = (bf16_t*)(ws + WS_GATES); bf16_t* ACT = (bf16_t*)(ws + WS_GATES); bf16_t* P1 = (bf16_t*)(ws + WS_P1); bf16_t* H = (bf16_t*)(ws + WS_H);
    bf16_t* Qb = (bf16_t*)(ws + WS_Q); bf16_t* Kb = (bf16_t*)(ws + WS_K); bf16_t* Vb = (bf16_t*)(ws + WS_V); bf16_t* T = (bf16_t*)(ws + WS_T);
    float* PB = (float*)(ws + WS_PB); float* PB2 = (float*)(ws + WS_ATT);
    bf16_t* QN = (bf16_t*)(ws + WS_QN); bf16_t* CKV = (bf16_t*)(ws + WS_CKV); bf16_t* CACT = (bf16_t*)(ws + WS_CACT); bf16_t* SACT = (bf16_t*)(ws + WS_SACT); bf16_t* ATT = (bf16_t*)(ws + WS_ATT);
    const int G = gridDim.x, cb = blockIdx.x;
    int ph = 0;
#define PHASE_BEGIN if (ph >= p.ph_lo && ph < p.ph_hi) { const int nrep_ = ((REPMASK >> ph) & 1) ? 2 : 1; for (int rep_ = 0; rep_ < nrep_; ++rep_) {
#define PHASE_END   if (ph + 1 < p.ph_hi || rep_ + 1 < nrep_) { if (p.ph_hi < 0) grid.sync(); else xcd_barrier(xbar); } } } ++ph;
#ifdef NO_GEMM
#define GEMM(ID, EpiT, Aptr, Bptr, M_, N_, K_, epi) do {} while (0)
#else
#define GEMM(ID, EpiT, Aptr, Bptr, M_, N_, K_, epi) do { if (ONLY_GEMM && ONLY_GEMM != ID) break; pg8::Gemm g_{Aptr, Bptr, M_, N_, K_, K_}; pg8::StaticOrder S_; S_.init(M_, N_, G, cb); \
        pg8::gemm_phase<EpiT, pg8::StaticOrder, true, true>(lds, g_, S_, epi); } while (0)
#endif

    for (int i_ = 0; i_ < NSYNC_EXTRA; ++i_) grid.sync();
    PHASE_BEGIN phase_mod(p, lds); PHASE_END
#pragma unroll 1
    for (int l = 0; l < DEPTH; ++l) {
        const bool last = (l == DEPTH - 1);
        const float* modl = modall + (size_t)l * 3 * NMOD;
        const float* xinL = (l == 0) ? p.x : p.out; const float* xinC = (l == 0) ? p.ctx : XC;
        const int Mfull = MT, Mlat = last ? ML : MT;
        PHASE_BEGIN phase_wconv(p, l, lds); if (l == 0) phase_norm<0>(p, xinL, xinC, p.ln1_g + l * D, modl, 0, MT, XC);
                    else phase_norm<0>(p, xinL, xinC, p.ln1_g + l * D, modl, 0, MT, XC, PB, 11, modall + (size_t)(l - 1) * 3 * NMOD + 2 * NMOD + 5 * D); PHASE_END
        PHASE_BEGIN { EpiProj e{P1, GATES};
                      if (!last) { GEMM(1, EpiProj, H, WinT, MT, NIN, D, e); }
                      else { GEMM(1, EpiProj, H, WinT, ML, NIN, D, e);
                             EpiPartialKV ek{PB2}; pg8::Gemm g_{H, WinT, MT, NIN, 256, D}; CtxKvOrder S_{G, cb};
                             pg8::gemm_phase<EpiPartialKV, CtxKvOrder, true, true>(lds, g_, S_, ek); } } PHASE_END
#ifndef NO_PREP
        PHASE_BEGIN phase_prep(p, l, lds, last ? PB2 : nullptr); PHASE_END
#endif
        PHASE_BEGIN { EpiQ eq{Qb, (const float*)(ws + WS_ROPE)}; GEMM(2, EpiQ, QN, WqT, Mlat, 768, QLORA, eq); EpiKV ek{Kb, Vb, (const bf16_t*)(ws + WS_KR)};
                      { pg8::Gemm g_{CKV, WkvT, Mfull, 1024, KVLORA, KVLORA}; pg8::StaticOrder S_; S_.init(Mfull, 1024, G, (cb + 58) % G);
                        pg8::gemm_phase<EpiKV, pg8::StaticOrder, true, true>(lds, g_, S_, ek); } } PHASE_END
#ifndef NO_ATTN
        PHASE_BEGIN {
            const int nunits = 512 + (last ? 0 : 16);
#pragma unroll 1
            for (int u = cb; u < nunits; u += G) {
                if (u < 512) { const int i = u >> 8, c8 = u & 255; const int bh = (c8 & 7) + 8 * i, qb = c8 >> 3; const int b = bh >> 3, h = bh & 7;
                    attn_unit(Qb + ((size_t)bh * NKEY + qb * 256) * DQK, Kb + (size_t)bh * NKEY * DQK, Vb + (size_t)bh * NKEY * DV, ATT + (size_t)(b * SEQ + qb * 256) * 512 + h * 64, NKEY, (char*)lds_raw); }
                else { const int bh = u - 512, b = bh >> 3, h = bh & 7;
                    attn_unit(Qb + ((size_t)bh * NKEY + SEQ) * DQK, Kb + ((size_t)bh * NKEY + SEQ) * DQK, Vb + ((size_t)bh * NKEY + SEQ) * DV, ATT + (size_t)(ML + b * CTX) * 512 + h * 64, CTX, (char*)lds_raw); }
            }
        } PHASE_END
#endif
        PHASE_BEGIN { EpiMerge<0> e0{T, GATES, 1}; GEMM(4, EpiMerge<0>, CACT, WcoT, Mlat, D, 256, e0); EpiMerge<1> e1{T, GATES, 2}; GEMM(5, EpiMerge<1>, SACT, WsoT, Mlat, D, 256, e1);
                      EpiMerge<1> e2{T, GATES, 0}; GEMM(6, EpiMerge<1>, ATT, WmoT, Mlat, D, 512, e2); } PHASE_END
        PHASE_BEGIN { EpiResid e{xinL, xinC, p.out, XC, modl + 2 * D}; GEMM(7, EpiResid, T, WoT, ML, D, D, e);
                      if (!last) { EpiPartial ea{PB}; pg8::Gemm g_{T, WoT, MT, D, 256, D}; CtxSplitOrder S_{4, G, cb};
                                   pg8::gemm_phase<EpiPartial, CtxSplitOrder, true, true>(lds, g_, S_, ea); } } PHASE_END
        PHASE_BEGIN if (last) phase_norm<0>(p, p.out, XC, p.ln2_g + l * D, modl, 3, Mlat); else phase_norm<0>(p, p.out, XC, p.ln2_g + l * D, modl, 3, Mlat, XC, PB, 4, modl + 2 * NMOD + 2 * D); PHASE_END
        PHASE_BEGIN { EpiSwiglu e{ACT}; GEMM(8, EpiSwiglu, H, W13T, Mlat, 2 * DFF, D, e); } PHASE_END
        PHASE_BEGIN { EpiResid e{p.out, XC, p.out, XC, modl + 5 * D}; GEMM(9, EpiResid, ACT, W2T, ML, D, DFF, e);
                      if (!last) { EpiPartial ea{PB}; pg8::Gemm g_{ACT, W2T, MT, D, 256, DFF}; CtxSplitOrder S_{11, G, cb};
                                   pg8::gemm_phase<EpiPartial, CtxSplitOrder, true, true>(lds, g_, S_, ea); } } PHASE_END
    }
    PHASE_BEGIN phase_norm<1>(p, p.out, XC, p.final_g, nullptr, 0, ML); PHASE_END
}
constexpr int NPHASES = 1 + DEPTH * 10 + 1;
}

extern "C" void kernel_launch(void* const* d_in, const int* in_sizes, int n_in, void* d_out, int out_size, void* d_ws, size_t ws_size, hipStream_t stream) {
    static int grid = 0;
    if (grid == 0) {
        if (n_in != 26 || out_size != mk::ML * mk::D || ws_size < mk::WS_END) { fprintf(stderr, "kernel_launch: unexpected shapes n_in %d out %d ws %zu (need %zu)\n", n_in, out_size, ws_size, (size_t)mk::WS_END); grid = -1; return; }
        int dev = 0, cus = 0, per_cu = 0;
        hipGetDevice(&dev); hipDeviceGetAttribute(&cus, hipDeviceAttributeMultiprocessorCount, dev);
        if (hipFuncSetAttribute((const void*)mk::mega_fwd, hipFuncAttributeMaxDynamicSharedMemorySize, mk::LDS_BYTES) != hipSuccess) { fprintf(stderr, "kernel_launch: hipFuncSetAttribute failed\n"); grid = -1; return; }
        hipOccupancyMaxActiveBlocksPerMultiprocessor(&per_cu, (const void*)mk::mega_fwd, 512, mk::LDS_BYTES);
        if (per_cu < 1) per_cu = 1;
        grid = cus * per_cu; if (grid > 256) grid = 256;
        (void)hipGetLastError();
        fprintf(stderr, "kernel_launch: cus %d per_cu %d grid %d\n", cus, per_cu, grid);
    }
    if (grid < 0) return;
    hipMemsetAsync(d_ws, 0, mk::WS_ZERO_BYTES, stream);
    mk::Params p{};
    const float** pp = (const float**)&p;
    for (int i = 0; i < 26; ++i) pp[i] = (const float*)d_in[i];
    p.out = (float*)d_out; p.ws = (unsigned char*)d_ws;
#if MK_MULTI
    for (int ph = 0; ph < mk::NPHASES; ++ph) { p.ph_lo = ph; p.ph_hi = ph + 1; hipLaunchKernelGGL(mk::mega_fwd, dim3(grid), dim3(512), mk::LDS_BYTES, stream, p); }
#else
    p.ph_lo = 0; p.ph_hi = mk::NPHASES;
    void* args[] = {&p};
    hipError_t e = hipLaunchCooperativeKernel((const void*)mk::mega_fwd, dim3(grid), dim3(512), args, mk::LDS_BYTES, stream);
    if (e != hipSuccess) fprintf(stderr, "cooperative launch failed: %s (grid %d)\n", hipGetErrorString(e), grid);
#endif
}
```

```cpp
#include <hip/hip_runtime.h>
#include <hip/hip_cooperative_groups.h>
#include <cstdio>
#include <cstdint>
#ifndef ONLY_GEMM
#define ONLY_GEMM 0
#endif
#ifndef REPMASK
#define REPMASK 0
#endif
#ifndef NSYNC_EXTRA
#define NSYNC_EXTRA 0
#endif
#ifndef MK_MULTI
#define MK_MULTI 0
#endif
namespace cg = cooperative_groups;
__device__ __forceinline__ int tid_fresh() { int t = threadIdx.x; asm volatile("" : "+v"(t)); return t; }
namespace pg8 {
#define PG8_LAS __attribute__((address_space(3)))
typedef unsigned short bf16_t;
typedef short bf16x8 __attribute__((ext_vector_type(8)));
typedef float f32x4 __attribute__((ext_vector_type(4)));
typedef unsigned u32x4 __attribute__((ext_vector_type(4)));
constexpr int BM = 256, BK = 64, HALF = 128, HTB = HALF * BK * 2  , STAGE_BYTES = 8 * HTB, NXCD = 8, WGM = 8;

__host__ __device__ __forceinline__ int lds_byte(int r, int c) { const int st = (r >> 4) * 2 + (c >> 5), rr = r & 15, cc = c & 31, ob = rr * 64 + cc * 2; return st * 1024 + (ob ^ (((ob >> 9) & 1) << 5)); }
__host__ __device__ __forceinline__ void stage_rc(int b, int& R, int& C) { const int st = b / 1024, sb = b % 1024, swz = sb ^ (((sb >> 9) & 1) << 5); R = (st >> 1) * 16 + swz / 64; C = (st & 1) * 32 + (swz % 64) / 2; }
__host__ __device__ __forceinline__ int perm32(int rho) { const int n = rho >> 4, i = rho & 15; return 8 * (i >> 2) + 4 * n + (i & 3); }

struct Unit { int pm, pn, ko; };
struct Gemm { const bf16_t* A; const bf16_t* Bt; int M, N, K, ld; };

struct StaticOrder {
    int nM, nN, nwg, G, c;
    __host__ __device__ void init(int M, int N, int G_, int c_) { nM = M / BM; nN = N / BM; nwg = nM * nN; G = G_; c = c_; }
    __host__ __device__ bool next(int i, Unit& u) const {
        const long L = (long)i * G + c; if (L >= nwg) return false;
        int wgid = (int)L; { const int q = nwg / NXCD, r = nwg % NXCD, xcd = wgid % NXCD, off = wgid / NXCD; wgid = (xcd < r ? xcd * (q + 1) : r * (q + 1) + (xcd - r) * q) + off; }
        const int nig = WGM * nN, gid = wgid / nig, fm = gid * WGM, gsz = (nM - fm) < WGM ? (nM - fm) : WGM;
        u.pm = fm + ((wgid % nig) % gsz); u.pn = (wgid % nig) / gsz; u.ko = 0; return true;
    }
    __device__ __forceinline__ void a_ready(const Unit&) const {}
    __device__ __forceinline__ void done(const Unit&) const {}
};

__device__ __forceinline__ unsigned cvt_pk_bf16(float lo, float hi) { unsigned r; asm volatile("v_cvt_pk_bf16_f32 %0, %1, %2" : "=v"(r) : "v"(lo), "v"(hi)); return r; }
typedef float f32x2 __attribute__((ext_vector_type(2)));
template <class Epi, class Sched, bool ALIGN_EPI = false, bool SP2 = false>
__device__ __forceinline__ void gemm_phase(PG8_LAS unsigned char* lds, const Gemm g, const Sched& S, const Epi& E) {
    const int tid = tid_fresh(), wid = __builtin_amdgcn_readfirstlane(tid >> 6), lane = tid & 63, wr = wid >> 2, wc = wid & 3, fr = lane & 15, fq = lane >> 4;
    const int K = g.K, nt = K / BK, LD = g.ld;
    unsigned voffA[2], voffB[2];
#pragma unroll
    for (int i = 0; i < 2; ++i) { int R, C; stage_rc(tid * 16 + i * 8192, R, C); const int Rb = Epi::PERM ? ((R & ~31) + perm32(R & 31)) : R;
        voffA[i] = (unsigned)(R * LD + C) * 2u; voffB[i] = (unsigned)(Rb * LD + C) * 2u; }
    const size_t kstep = (size_t)(BK * 2);
    const size_t hstep = (size_t)HALF * LD * 2;
    const size_t tstep = 2 * hstep;
    const unsigned ldsw = (unsigned)wid * 1024u;
    const int aoff = lds_byte(wr * 64 + fr, fq * 8), boff = lds_byte(wc * 32 + fr, fq * 8);
#define PG8_SA(b, h) (((b) * 2 + (h)) * HTB)
#define PG8_SB(b, h) ((4 + (b) * 2 + (h)) * HTB)
#define PG8_STAGE(bufoff, gbase, voff) do { _Pragma("unroll") for (int _i = 0; _i < 2; ++_i) \
        __builtin_amdgcn_global_load_lds((const unsigned*)((const char*)(gbase) + (voff)[_i]), (PG8_LAS unsigned*)(lds + (bufoff) + ldsw + _i * 8192), 16, 0, 0); } while (0)
#define PG8_LDA(dst, b, h) do { _Pragma("unroll") for (int m = 0; m < 4; ++m) _Pragma("unroll") for (int k = 0; k < 2; ++k) dst[m][k] = *(const PG8_LAS bf16x8*)(lds + PG8_SA(b, h) + aoff + m * 2048 + k * 1024); } while (0)
#define PG8_LDB(dst, b, h) do { _Pragma("unroll") for (int n = 0; n < 2; ++n) _Pragma("unroll") for (int k = 0; k < 2; ++k) dst[n][k] = *(const PG8_LAS bf16x8*)(lds + PG8_SB(b, h) + boff + n * 2048 + k * 1024); } while (0)
#define PG8_MMA(ai, bj, At, Bt) do { __builtin_amdgcn_s_setprio(1); _Pragma("unroll") for (int m = 0; m < 4; ++m) _Pragma("unroll") for (int n = 0; n < 2; ++n) _Pragma("unroll") for (int k = 0; k < 2; ++k) \
        acc[ai][bj][m][n] = __builtin_amdgcn_mfma_f32_16x16x32_bf16(Bt[n][k], At[m][k], acc[ai][bj][m][n], 0, 0, 0); __builtin_amdgcn_s_setprio(0); } while (0)
#define PG8_WAIT_V(n) asm volatile("s_waitcnt vmcnt(" #n ")" ::: "memory")
#define PG8_WAIT_L(n) asm volatile("s_waitcnt lgkmcnt(" #n ")" ::: "memory")
#define PG8_BAR __builtin_amdgcn_s_barrier()
#define PG8_SCHED __builtin_amdgcn_sched_barrier(0)
    Unit cur, nxt; int ui = 0;
    if (!S.next(0, cur)) return;
    f32x4 acc[2][2][4][2];
#pragma unroll
    for (int a = 0; a < 2; ++a)
#pragma unroll
        for (int b = 0; b < 2; ++b)
#pragma unroll
            for (int m = 0; m < 4; ++m)
#pragma unroll
                for (int n = 0; n < 2; ++n) acc[a][b][m][n] = (f32x4){0.f, 0.f, 0.f, 0.f};
    bf16x8 At[4][2], B0[2][2], B1[2][2];
    const char* cA = (const char*)g.A + (size_t)cur.pm * tstep + (size_t)cur.ko * 2; const char* cB = (const char*)g.Bt + (size_t)cur.pn * tstep + (size_t)cur.ko * 2;
    S.a_ready(cur);
    if constexpr (SP2) {
        PG8_STAGE(PG8_SB(0, 0), cB, voffB); PG8_STAGE(PG8_SB(0, 1), cB + hstep, voffB); PG8_STAGE(PG8_SA(0, 0), cA, voffA); PG8_STAGE(PG8_SA(0, 1), cA + hstep, voffA);
        if (wr == 1) PG8_BAR;
        PG8_WAIT_V(2); PG8_BAR;
        PG8_STAGE(PG8_SB(1, 0), cB + kstep, voffB); PG8_STAGE(PG8_SA(1, 0), cA + kstep, voffA); PG8_STAGE(PG8_SB(1, 1), cB + hstep + kstep, voffB);
        PG8_WAIT_V(6); PG8_BAR;
    } else {
        PG8_STAGE(PG8_SB(0, 0), cB, voffB); PG8_STAGE(PG8_SA(0, 0), cA, voffA); PG8_STAGE(PG8_SB(0, 1), cB + hstep, voffB); PG8_STAGE(PG8_SA(0, 1), cA + hstep, voffA);
        if (wr == 1) PG8_BAR;
        PG8_WAIT_V(4); PG8_BAR;
        PG8_STAGE(PG8_SB(1, 0), cB + kstep, voffB); PG8_STAGE(PG8_SA(1, 0), cA + kstep, voffA); PG8_STAGE(PG8_SB(1, 1), cB + hstep + kstep, voffB);
        PG8_WAIT_V(6); PG8_BAR;
    }
    for (;;) {
        const bool has_next = S.next(ui + 1, nxt);
        const char* nA = has_next ? (const char*)g.A + (size_t)nxt.pm * tstep + (size_t)nxt.ko * 2 : cA; const char* nB = has_next ? (const char*)g.Bt + (size_t)nxt.pn * tstep + (size_t)nxt.ko * 2 : cB;
#pragma unroll 1
        for (int t = 0; t < nt; t += 2) {
            const bool last = (t == nt - 2);
            const char* a1 = cA + (size_t)(t + 1) * kstep;
            const char* a2 = last ? nA : cA + (size_t)(t + 2) * kstep; const char* b2 = last ? nB : cB + (size_t)(t + 2) * kstep;
            const char* a3 = a2 + kstep; const char* b3 = b2 + kstep;
            if (last && has_next) S.a_ready(nxt);
            if constexpr (SP2) {
            PG8_LDB(B0, 0, 0); PG8_LDB(B1, 0, 1); PG8_SCHED; PG8_LDA(At, 0, 0); PG8_STAGE(PG8_SA(1, 1), a1 + hstep, voffA);
            PG8_WAIT_V(8); PG8_WAIT_L(0); PG8_BAR; PG8_MMA(0, 0, At, B0); PG8_MMA(0, 1, At, B1); PG8_BAR; PG8_SCHED;
            PG8_LDA(At, 0, 1); PG8_STAGE(PG8_SB(0, 0), b2, voffB); PG8_STAGE(PG8_SB(0, 1), b2 + hstep, voffB); PG8_STAGE(PG8_SA(0, 0), a2, voffA);
            PG8_WAIT_V(8); PG8_WAIT_L(0); PG8_BAR; PG8_MMA(1, 0, At, B0); PG8_MMA(1, 1, At, B1); PG8_BAR; PG8_SCHED;
            PG8_LDB(B0, 1, 0); PG8_LDB(B1, 1, 1); PG8_SCHED; PG8_LDA(At, 1, 0); PG8_STAGE(PG8_SA(0, 1), a2 + hstep, voffA);
            PG8_WAIT_V(8); PG8_WAIT_L(0); PG8_BAR; PG8_MMA(0, 0, At, B0); PG8_MMA(0, 1, At, B1); PG8_BAR; PG8_SCHED;
            PG8_LDA(At, 1, 1); PG8_STAGE(PG8_SB(1, 0), b3, voffB); PG8_STAGE(PG8_SB(1, 1), b3 + hstep, voffB); PG8_STAGE(PG8_SA(1, 0), a3, voffA);
            PG8_WAIT_V(8); PG8_WAIT_L(0); PG8_BAR; PG8_MMA(1, 0, At, B0); PG8_MMA(1, 1, At, B1); PG8_BAR; PG8_SCHED;
            } else {
            PG8_LDB(B0, 0, 0); PG8_SCHED; PG8_LDA(At, 0, 0); PG8_STAGE(PG8_SA(1, 1), a1 + hstep, voffA);
            PG8_WAIT_L(8); PG8_BAR; PG8_WAIT_L(0); PG8_MMA(0, 0, At, B0); PG8_BAR; PG8_SCHED;
            PG8_LDB(B1, 0, 1); PG8_STAGE(PG8_SB(0, 0), b2, voffB);
            PG8_BAR; PG8_WAIT_L(0); PG8_MMA(0, 1, At, B1); PG8_BAR;
            PG8_LDA(At, 0, 1); PG8_STAGE(PG8_SA(0, 0), a2, voffA);
            PG8_BAR; PG8_WAIT_L(0); PG8_MMA(1, 0, At, B0); PG8_BAR; PG8_SCHED;
            PG8_STAGE(PG8_SB(0, 1), b2 + hstep, voffB);
            PG8_WAIT_V(6); PG8_BAR; PG8_MMA(1, 1, At, B1); PG8_BAR;
            PG8_LDB(B0, 1, 0); PG8_SCHED; PG8_LDA(At, 1, 0); PG8_STAGE(PG8_SA(0, 1), a2 + hstep, voffA);
            PG8_WAIT_L(8); PG8_BAR; PG8_WAIT_L(0); PG8_MMA(0, 0, At, B0); PG8_BAR; PG8_SCHED;
            PG8_LDB(B1, 1, 1); PG8_STAGE(PG8_SB(1, 0), b3, voffB);
            PG8_BAR; PG8_WAIT_L(0); PG8_MMA(0, 1, At, B1); PG8_BAR;
            PG8_LDA(At, 1, 1); PG8_STAGE(PG8_SA(1, 0), a3, voffA);
            PG8_BAR; PG8_WAIT_L(0); PG8_MMA(1, 0, At, B0); PG8_BAR; PG8_SCHED;
            PG8_STAGE(PG8_SB(1, 1), b3 + hstep, voffB);
            PG8_WAIT_V(6); PG8_BAR; PG8_MMA(1, 1, At, B1); PG8_BAR;
            }
        }
        if constexpr (ALIGN_EPI) { if (wr == 0) PG8_BAR; }
        if constexpr (!Epi::AFTER_DRAIN) { E(acc, cur, wr, wc, fr, fq); S.done(cur); }
        if (!has_next) break;
#pragma unroll
        for (int a = 0; a < 2; ++a)
#pragma unroll
            for (int b = 0; b < 2; ++b)
#pragma unroll
                for (int m = 0; m < 4; ++m)
#pragma unroll
                    for (int n = 0; n < 2; ++n) acc[a][b][m][n] = (f32x4){0.f, 0.f, 0.f, 0.f};
        cur = nxt; cA = nA; cB = nB; ++ui;
        if constexpr (ALIGN_EPI) { if (wr == 1) PG8_BAR; }
    }
    PG8_WAIT_V(0);
    if constexpr (!ALIGN_EPI) { if (wr == 0) PG8_BAR; }
    PG8_BAR;
    if constexpr (Epi::AFTER_DRAIN) { E.fused(acc, cur, wr, wc, fr, fq, lds, wid, lane); S.done(cur); }
#undef PG8_SA
#undef PG8_SB
#undef PG8_STAGE
#undef PG8_LDA
#undef PG8_LDB
#undef PG8_MMA
#undef PG8_WAIT_V
#undef PG8_WAIT_L
#undef PG8_BAR
#undef PG8_SCHED
}
}

namespace mk {
using pg8::bf16_t; using pg8::bf16x8; using pg8::f32x4; using pg8::u32x4; using pg8::cvt_pk_bf16;
typedef float f32x2 __attribute__((ext_vector_type(2)));
typedef unsigned u32x2 __attribute__((ext_vector_type(2)));
typedef float f32x16 __attribute__((ext_vector_type(16)));
typedef float f32x8 __attribute__((ext_vector_type(8)));
typedef short s16x4 __attribute__((ext_vector_type(4)));
#define LAS __attribute__((address_space(3)))

constexpr int D = 1024, SEQ = 8192, NB = 2, CTX = 256, DEPTH = 2;
constexpr int ML = NB * SEQ, MC = NB * CTX, MT = ML + MC;
constexpr int NH = 8, DQK = 96, DV = 64, QLORA = 384, KVLORA = 256, NKEY = SEQ + CTX;
constexpr int INC = 5024, NP1 = 2048, NGATE = 3072, NIN = 5120, DFF = 2816, NMOD = 6144;
constexpr float EPS = 1e-6f;
constexpr float ATT_SCALE = 0.10206207261596577f;
constexpr float QSCALE = ATT_SCALE * 1.4426950408889634f;
constexpr size_t MiB = 1u << 20;
constexpr size_t WS_MOD = 0;
constexpr size_t WS_BAR = 148 * 1024;
constexpr size_t WS_ZERO_BYTES = 192 * 1024;
constexpr size_t WS_ROPE = 192 * 1024;
constexpr size_t WS_XCTX = 1 * MiB;
constexpr size_t WS_W = 3 * MiB;
constexpr size_t W_IN = 0, W_Q = W_IN + (size_t)NIN * D * 2, W_KV = W_Q + (size_t)768 * QLORA * 2, W_MO = W_KV + (size_t)1024 * KVLORA * 2,
                 W_CO = W_MO + (size_t)1024 * 512 * 2, W_SO = W_CO + (size_t)1024 * 256 * 2, W_O = W_SO + (size_t)1024 * 256 * 2,
                 W_13 = W_O + (size_t)1024 * 1024 * 2, W_2 = W_13 + (size_t)2 * DFF * D * 2, W_END = W_2 + (size_t)D * DFF * 2;
static_assert(WS_BAR + 3456 * 4 <= WS_ZERO_BYTES && WS_BAR >= 147456, "ctl");
static_assert(WS_W + W_END <= 36 * MiB, "weights");
constexpr size_t WS_GATES = 36 * MiB;
constexpr size_t WS_R = 135 * MiB;
static_assert(WS_GATES + (size_t)MT * NGATE * 2 <= WS_R, "gates");
constexpr size_t WS_P1 = WS_R;
constexpr size_t WS_Q = WS_R, WS_K = WS_Q + (size_t)NB * NH * NKEY * DQK * 2, WS_V = WS_K + (size_t)NB * NH * NKEY * DQK * 2;
constexpr size_t WS_T = WS_R;
constexpr size_t WS_PB = WS_R + 34 * MiB;
constexpr size_t WS_H = WS_R + 66 * MiB;
static_assert(WS_V + (size_t)NB * NH * NKEY * DV * 2 <= WS_H && WS_P1 + (size_t)MT * NP1 * 2 <= WS_H, "P1/QKV");
constexpr size_t WS_QN = WS_H;
constexpr size_t WS_CKV = WS_QN + (size_t)MT * QLORA * 2, WS_CACT = WS_CKV + (size_t)MT * 256 * 2, WS_SACT = WS_CACT + (size_t)MT * 256 * 2,
                 WS_ATT = WS_SACT + (size_t)MT * 256 * 2, WS_KR = WS_ATT + (size_t)MT * 512 * 2, WS_END = WS_KR + (size_t)MT * 32 * 2;
static_assert(WS_END <= 256 * MiB, "workspace");
static_assert(WS_PB >= WS_T + (size_t)MT * D * 2 && WS_PB + (size_t)11 * MC * D * 4 <= WS_H, "PB");

constexpr int LDS_BYTES = 147456;

struct Params {
    const float *x, *c, *ctx, *c_ctx, *w_mod, *b_mod, *ln1_g, *w_in, *q_g, *w_q_b, *kv_g, *w_kv_b, *w_mla_o, *conv_dw, *conv_dw_b, *conv_ln_g, *conv_ln_b,
                *w_conv_o, *sc_dw, *w_sc_o, *w_o, *ln2_g, *w_ff1, *w_ff3, *w_ff2, *final_g;
    float* out; unsigned char* ws;
    int ph_lo, ph_hi;
};

__device__ __forceinline__ float wave_sum(float v) {
#pragma unroll
    for (int o = 1; o < 64; o <<= 1) v += __shfl_xor(v, o);
    return v;
}
__device__ __forceinline__ float bf2f(unsigned short b) { return __uint_as_float((unsigned)b << 16); }
__device__ __forceinline__ float bflo(unsigned w) { return __uint_as_float(w << 16); }
__device__ __forceinline__ float bfhi(unsigned w) { return __uint_as_float(w & 0xffff0000u); }
__device__ __forceinline__ float sigmoidf_(float x) { return __builtin_amdgcn_rcpf(1.f + __builtin_amdgcn_exp2f(-1.4426950408889634f * x)); }
__device__ __forceinline__ float siluf_(float x) { return x * sigmoidf_(x); }
__device__ __forceinline__ int rowgroup(int pm) { return pm < 32 ? 0 : (pm < 64 ? 1 : 2); }

struct EpiProj {
    static constexpr bool PERM = true, AFTER_DRAIN = false;
    bf16_t* P1; bf16_t* G;
    __device__ __forceinline__ void operator()(const f32x4 (&acc)[2][2][4][2], const pg8::Unit& u, int wr, int wc, int fr, int fq) const {
        const int row0 = u.pm * 256 + wr * 64 + fr; const bool gate = u.pn >= 8;
        bf16_t* base = gate ? G + (size_t)row0 * NGATE + (u.pn - 8) * 256 + wc * 32 + fq * 8 : P1 + (size_t)row0 * NP1 + u.pn * 256 + wc * 32 + fq * 8;
        const size_t ld = gate ? NGATE : NP1;
#pragma unroll
        for (int ai = 0; ai < 2; ++ai)
#pragma unroll
            for (int m = 0; m < 4; ++m) { bf16_t* rp = base + (size_t)(ai * 128 + m * 16) * ld;
#pragma unroll
                for (int bj = 0; bj < 2; ++bj) { f32x4 v0 = acc[ai][bj][m][0], v1 = acc[ai][bj][m][1];
                    if (gate) {
#pragma unroll
                        for (int i = 0; i < 4; ++i) { v0[i] = sigmoidf_(v0[i]); v1[i] = sigmoidf_(v1[i]); } }
                    u32x4 w; w.x = cvt_pk_bf16(v0[0], v0[1]); w.y = cvt_pk_bf16(v0[2], v0[3]); w.z = cvt_pk_bf16(v1[0], v1[1]); w.w = cvt_pk_bf16(v1[2], v1[3]);
                    *(u32x4*)(rp + bj * 128) = w; } }
    }
};
__device__ __forceinline__ void row_to_bq(int row, int& b, int& qi) { if (row < ML) { b = row >> 13; qi = row & (SEQ - 1); } else { const int r2 = row - ML; b = r2 >> 8; qi = SEQ + (r2 & 255); } }

struct EpiQ {
    static constexpr bool PERM = true, AFTER_DRAIN = false;
    bf16_t* Q; const float* rope;
    __device__ __forceinline__ void operator()(const f32x4 (&acc)[2][2][4][2], const pg8::Unit& u, int wr, int wc, int fr, int fq) const {
        const bool latent = u.pm < 64;
#pragma unroll
        for (int bj = 0; bj < 2; ++bj) {
            const int g32 = 8 * u.pn + 4 * bj + wc, h = g32 / 3, sub = g32 - 3 * h; const int d0 = sub * 32 + fq * 8;
            const bool dorope = latent && (sub == 2);
#pragma unroll
            for (int ai = 0; ai < 2; ++ai)
#pragma unroll
                for (int m = 0; m < 4; ++m) {
                    const int row = u.pm * 256 + ai * 128 + wr * 64 + m * 16 + fr; int b, qi; row_to_bq(row, b, qi);
                    f32x4 v0 = acc[ai][bj][m][0], v1 = acc[ai][bj][m][1];
                    if (dorope) {
                        const int pos = (fq >> 1) ? (qi & 63) : (qi >> 6); const bool isx2 = fq & 1;
                        const f32x4 c0 = *(const f32x4*)(rope + pos * 8), c1 = *(const f32x4*)(rope + pos * 8 + 4), s0 = *(const f32x4*)(rope + 1024 + pos * 8), s1 = *(const f32x4*)(rope + 1024 + pos * 8 + 4);
#pragma unroll
                        for (int i = 0; i < 4; ++i) {
                            const float p0 = __shfl_xor(v0[i], 16), p1 = __shfl_xor(v1[i], 16);
                            v0[i] = isx2 ? p0 * s0[i] + v0[i] * c0[i] : v0[i] * c0[i] - p0 * s0[i];
                            v1[i] = isx2 ? p1 * s1[i] + v1[i] * c1[i] : v1[i] * c1[i] - p1 * s1[i]; }
                    }
                    v0 = v0 * QSCALE; v1 = v1 * QSCALE;
                    u32x4 w; w.x = cvt_pk_bf16(v0[0], v0[1]); w.y = cvt_pk_bf16(v0[2], v0[3]); w.z = cvt_pk_bf16(v1[0], v1[1]); w.w = cvt_pk_bf16(v1[2], v1[3]);
                    *(u32x4*)(Q + ((size_t)(b * NH + h) * NKEY + qi) * DQK + d0) = w; asm volatile("" ::: "memory"); }
        }
    }
};
struct EpiKV {
    static constexpr bool PERM = true, AFTER_DRAIN = false;
    bf16_t* K; bf16_t* V; const bf16_t* KR;
    __device__ __forceinline__ void operator()(const f32x4 (&acc)[2][2][4][2], const pg8::Unit& u, int wr, int wc, int fr, int fq) const {
#pragma unroll
        for (int bj = 0; bj < 2; ++bj) { const int h = 2 * u.pn + bj; const int jp = wc * 32 + fq * 8;
#pragma unroll
            for (int ai = 0; ai < 2; ++ai)
#pragma unroll
                for (int m = 0; m < 4; ++m) {
                    const int row = u.pm * 256 + ai * 128 + wr * 64 + m * 16 + fr; int b, qi; row_to_bq(row, b, qi);
                    const f32x4 v0 = acc[ai][bj][m][0], v1 = acc[ai][bj][m][1];
                    u32x4 w; w.x = cvt_pk_bf16(v0[0], v0[1]); w.y = cvt_pk_bf16(v0[2], v0[3]); w.z = cvt_pk_bf16(v1[0], v1[1]); w.w = cvt_pk_bf16(v1[2], v1[3]);
                    bf16_t* dst = (wc < 2) ? K + ((size_t)(b * NH + h) * NKEY + qi) * DQK + jp : V + ((size_t)(b * NH + h) * NKEY + qi) * DV + (jp - 64);
                    *(u32x4*)dst = w;
                    if (wc == 0) *(u32x4*)(K + ((size_t)(b * NH + h) * NKEY + qi) * DQK + 64 + fq * 8) = *(const u32x4*)(KR + (size_t)row * 32 + fq * 8);
                    asm volatile("" ::: "memory"); }
        }
    }
};
template <int MODE> struct EpiMerge {
    static constexpr bool PERM = true, AFTER_DRAIN = false;
    bf16_t* T; const bf16_t* G; int br;
    __device__ __forceinline__ void operator()(const f32x4 (&acc)[2][2][4][2], const pg8::Unit& u, int wr, int wc, int fr, int fq) const {
#pragma unroll
        for (int ai = 0; ai < 2; ++ai)
#pragma unroll
            for (int m = 0; m < 4; ++m) { const int row = u.pm * 256 + ai * 128 + wr * 64 + m * 16 + fr;
#pragma unroll
                for (int bj = 0; bj < 2; ++bj) { const int col = u.pn * 256 + bj * 128 + wc * 32 + fq * 8;
                    const u32x4 gw = *(const u32x4*)(G + (size_t)row * NGATE + br * 1024 + col);
                    const f32x4 a0 = acc[ai][bj][m][0], a1 = acc[ai][bj][m][1];
                    float r[8] = {bflo(gw.x) * a0[0], bfhi(gw.x) * a0[1], bflo(gw.y) * a0[2], bfhi(gw.y) * a0[3], bflo(gw.z) * a1[0], bfhi(gw.z) * a1[1], bflo(gw.w) * a1[2], bfhi(gw.w) * a1[3]};
                    bf16_t* tp = T + (size_t)row * D + col;
                    if (MODE == 1) { const u32x4 tw = *(const u32x4*)tp;
                        r[0] += bflo(tw.x); r[1] += bfhi(tw.x); r[2] += bflo(tw.y); r[3] += bfhi(tw.y); r[4] += bflo(tw.z); r[5] += bfhi(tw.z); r[6] += bflo(tw.w); r[7] += bfhi(tw.w); }
                    u32x4 w; w.x = cvt_pk_bf16(r[0], r[1]); w.y = cvt_pk_bf16(r[2], r[3]); w.z = cvt_pk_bf16(r[4], r[5]); w.w = cvt_pk_bf16(r[6], r[7]);
                    *(u32x4*)tp = w; } asm volatile("" ::: "memory"); }
    }
};
struct EpiResid {
    static constexpr bool PERM = true, AFTER_DRAIN = false;
    const float* inL; const float* inC; float* outL; float* outC; const float* gvec;
    __device__ __forceinline__ void operator()(const f32x4 (&acc)[2][2][4][2], const pg8::Unit& u, int wr, int wc, int fr, int fq) const {
        const bool lat = u.pm < 64; const float* gp = gvec + rowgroup(u.pm) * NMOD;
        const float* ib = lat ? inL : inC - (size_t)ML * D; float* ob = lat ? outL : outC - (size_t)ML * D;
#pragma unroll
        for (int bj = 0; bj < 2; ++bj) { const int col = u.pn * 256 + bj * 128 + wc * 32 + fq * 8;
            const f32x4 g0 = *(const f32x4*)(gp + col), g1 = *(const f32x4*)(gp + col + 4);
#pragma unroll
            for (int ai = 0; ai < 2; ++ai)
#pragma unroll
                for (int m = 0; m < 4; ++m) { const int row = u.pm * 256 + ai * 128 + wr * 64 + m * 16 + fr; const size_t off = (size_t)row * D + col;
                    const f32x4 x0 = *(const f32x4*)(ib + off), x1 = *(const f32x4*)(ib + off + 4);
                    *(f32x4*)(ob + off) = x0 + g0 * acc[ai][bj][m][0]; *(f32x4*)(ob + off + 4) = x1 + g1 * acc[ai][bj][m][1]; }
        }
    }
};
struct CtxSplitOrder {
    int nsplit, G, c;
    __device__ bool next(int i, pg8::Unit& u) const { const int L = i * G + c; if (L >= 8 * nsplit) return false; u.pm = 64 + (L & 1); u.pn = (L >> 1) & 3; u.ko = (L >> 3) * 256; return true; }
    __device__ __forceinline__ void a_ready(const pg8::Unit&) const {}
    __device__ __forceinline__ void done(const pg8::Unit&) const {}
};
struct EpiPartial {
    static constexpr bool PERM = true, AFTER_DRAIN = false;
    float* PB;
    __device__ __forceinline__ void operator()(const f32x4 (&acc)[2][2][4][2], const pg8::Unit& u, int wr, int wc, int fr, int fq) const {
        float* base = PB + (size_t)(u.ko >> 8) * MC * D;
#pragma unroll
        for (int bj = 0; bj < 2; ++bj) { const int col = u.pn * 256 + bj * 128 + wc * 32 + fq * 8;
#pragma unroll
            for (int ai = 0; ai < 2; ++ai)
#pragma unroll
                for (int m = 0; m < 4; ++m) { const int row = u.pm * 256 + ai * 128 + wr * 64 + m * 16 + fr - ML; float* o = base + (size_t)row * D + col;
                    *(f32x4*)o = acc[ai][bj][m][0]; *(f32x4*)(o + 4) = acc[ai][bj][m][1]; }
        }
    }
};
struct CtxKvOrder {
    int G, c;
    __device__ bool next(int i, pg8::Unit& u) const { const int L = i * G + c; if (L >= 16) return false; u.pm = 64 + (L & 1); u.pn = 1 + ((L >> 1) & 1); u.ko = (L >> 2) * 256; return true; }
    __device__ __forceinline__ void a_ready(const pg8::Unit&) const {}
    __device__ __forceinline__ void done(const pg8::Unit&) const {}
};
struct EpiPartialKV {
    static constexpr bool PERM = true, AFTER_DRAIN = false;
    float* PB2;
    __device__ __forceinline__ void operator()(const f32x4 (&acc)[2][2][4][2], const pg8::Unit& u, int wr, int wc, int fr, int fq) const {
        float* base = PB2 + (size_t)(u.ko >> 8) * MC * 512;
#pragma unroll
        for (int bj = 0; bj < 2; ++bj) { const int col = (u.pn - 1) * 256 + bj * 128 + wc * 32 + fq * 8;
#pragma unroll
            for (int ai = 0; ai < 2; ++ai)
#pragma unroll
                for (int m = 0; m < 4; ++m) { const int row = u.pm * 256 + ai * 128 + wr * 64 + m * 16 + fr - ML; float* o = base + (size_t)row * 512 + col;
                    *(f32x4*)o = acc[ai][bj][m][0]; *(f32x4*)(o + 4) = acc[ai][bj][m][1]; }
        }
    }
};
struct EpiSwiglu {
    static constexpr bool PERM = true, AFTER_DRAIN = false;
    bf16_t* ACT;
    __device__ __forceinline__ void operator()(const f32x4 (&acc)[2][2][4][2], const pg8::Unit& u, int wr, int wc, int fr, int fq) const {
        const int col = u.pn * 128 + wc * 32 + fq * 8;
#pragma unroll
        for (int ai = 0; ai < 2; ++ai)
#pragma unroll
            for (int m = 0; m < 4; ++m) { const int row = u.pm * 256 + ai * 128 + wr * 64 + m * 16 + fr;
                const f32x4 a0 = acc[ai][0][m][0], a1 = acc[ai][0][m][1], b0 = acc[ai][1][m][0], b1 = acc[ai][1][m][1];
                float r[8];
#pragma unroll
                for (int i = 0; i < 4; ++i) { r[i] = siluf_(a0[i]) * b0[i]; r[4 + i] = siluf_(a1[i]) * b1[i]; }
                u32x4 w; w.x = cvt_pk_bf16(r[0], r[1]); w.y = cvt_pk_bf16(r[2], r[3]); w.z = cvt_pk_bf16(r[4], r[5]); w.w = cvt_pk_bf16(r[6], r[7]);
                *(u32x4*)(ACT + (size_t)row * DFF + col) = w; }
    }
};

constexpr int NW = 8, QBLK = 32, KVBLK = 64;
constexpr float ATT_THR = 8.f;
constexpr float THRL = ATT_THR * 1.4426950408889634f;
constexpr int SHM_V = KVBLK * DV * 2  , SHM_K = KVBLK * 256  ;
#define KSWZ(row, colB) ((row) * 256 + ((colB) ^ (((row) & 15) << 4)))
#define SBAR() __builtin_amdgcn_sched_barrier(0)
__device__ __forceinline__ int crow(int r, int hi) { return (r & 3) + 8 * (r >> 2) + 4 * hi; }
template <bool FIRST>
__device__ __forceinline__ void partialSM(f32x16& p0, f32x16& p1, float& m_reg, float& alpha, f32x16& negm) {
    float pmax = p0[0];
#pragma unroll
    for (int r = 1; r < 16; ++r) pmax = fmaxf(pmax, p0[r]);
#pragma unroll
    for (int r = 0; r < 16; ++r) pmax = fmaxf(pmax, p1[r]);
    { auto rr = __builtin_amdgcn_permlane32_swap(__float_as_uint(pmax), __float_as_uint(pmax), false, false);
      pmax = fmaxf(__uint_as_float(rr[0]), __uint_as_float(rr[1])); }
    if (!FIRST && __builtin_expect(__all(pmax <= THRL), 1)) { alpha = 1.f; }
    else { const float d = FIRST ? pmax : fmaxf(pmax, 0.f); alpha = FIRST ? 1.f : __builtin_amdgcn_exp2f(-d); m_reg += d;
#pragma unroll
        for (int r = 0; r < 16; ++r) { p0[r] -= d; p1[r] -= d; }
#pragma unroll
        for (int r = 0; r < 16; ++r) negm[r] = -m_reg; }
#pragma unroll
    for (int r = 0; r < 16; ++r) p0[r] = __builtin_amdgcn_exp2f(p0[r]);
}
__device__ __forceinline__ void finishSM(f32x16& p0, f32x16& p1, float alpha, float& l_reg, bf16x8& pa0, bf16x8& pa1, bf16x8& pa2, bf16x8& pa3) {
#pragma unroll
    for (int r = 0; r < 16; ++r) p1[r] = __builtin_amdgcn_exp2f(p1[r]);
    float ps = 0;
#pragma unroll
    for (int r = 0; r < 16; ++r) ps += p0[r];
#pragma unroll
    for (int r = 0; r < 16; ++r) ps += p1[r];
    { auto rr = __builtin_amdgcn_permlane32_swap(__float_as_uint(ps), __float_as_uint(ps), false, false);
      ps = __uint_as_float(rr[0]) + __uint_as_float(rr[1]); }
    l_reg = l_reg * alpha + ps;
#define PK4(P, BASE, OUT) do { unsigned a0 = cvt_pk_bf16(P[BASE + 0], P[BASE + 1]), a1 = cvt_pk_bf16(P[BASE + 2], P[BASE + 3]);   \
    unsigned b0 = cvt_pk_bf16(P[BASE + 4], P[BASE + 5]), b1 = cvt_pk_bf16(P[BASE + 6], P[BASE + 7]);                              \
    auto r0 = __builtin_amdgcn_permlane32_swap(a0, b0, false, false); auto r1 = __builtin_amdgcn_permlane32_swap(a1, b1, false, false); \
    u32x4 w = {r0[0], r1[0], r0[1], r1[1]}; OUT = *reinterpret_cast<bf16x8*>(&w); } while (0)
    PK4(p0, 0, pa0); PK4(p0, 8, pa1); PK4(p1, 0, pa2); PK4(p1, 8, pa3);
#undef PK4
}
__device__ __forceinline__ void qkt(f32x16& p0, f32x16& p1, const char* Ks, const bf16x8* qr, const f32x16& negm, int r32, int hi) {
#define KF(d0, half) (*reinterpret_cast<const bf16x8*>(Ks + KSWZ((half) * 32 + r32, ((d0) * 16 + hi * 8) * 2)))
    bf16x8 a0 = KF(0, 0), a1 = KF(0, 1), b0 = KF(1, 0), b1 = KF(1, 1);
    SBAR();
    p0 = __builtin_amdgcn_mfma_f32_32x32x16_bf16(a0, qr[0], negm, 0, 0, 0); p1 = __builtin_amdgcn_mfma_f32_32x32x16_bf16(a1, qr[0], negm, 0, 0, 0);
    a0 = KF(2, 0); a1 = KF(2, 1);
    p0 = __builtin_amdgcn_mfma_f32_32x32x16_bf16(b0, qr[1], p0, 0, 0, 0);   p1 = __builtin_amdgcn_mfma_f32_32x32x16_bf16(b1, qr[1], p1, 0, 0, 0);
    b0 = KF(3, 0); b1 = KF(3, 1);
    p0 = __builtin_amdgcn_mfma_f32_32x32x16_bf16(a0, qr[2], p0, 0, 0, 0);   p1 = __builtin_amdgcn_mfma_f32_32x32x16_bf16(a1, qr[2], p1, 0, 0, 0);
    a0 = KF(4, 0); a1 = KF(4, 1);
    p0 = __builtin_amdgcn_mfma_f32_32x32x16_bf16(b0, qr[3], p0, 0, 0, 0);   p1 = __builtin_amdgcn_mfma_f32_32x32x16_bf16(b1, qr[3], p1, 0, 0, 0);
    b0 = KF(5, 0); b1 = KF(5, 1);
    p0 = __builtin_amdgcn_mfma_f32_32x32x16_bf16(a0, qr[4], p0, 0, 0, 0);   p1 = __builtin_amdgcn_mfma_f32_32x32x16_bf16(a1, qr[4], p1, 0, 0, 0);
    p0 = __builtin_amdgcn_mfma_f32_32x32x16_bf16(b0, qr[5], p0, 0, 0, 0);   p1 = __builtin_amdgcn_mfma_f32_32x32x16_bf16(b1, qr[5], p1, 0, 0, 0);
#undef KF
}
__device__ __forceinline__ int v_st(int k, int c) { const int kk = (k & ~0xC) | ((k & 4) << 1) | ((k & 8) >> 1); return ((kk >> 3) * 2 + (c >> 5)) * 512 + ((kk & 7) * 32 + (c & 31)) * 2; }
__device__ __forceinline__ int v_rd_base(int lane) { return ((lane & 3) << 3) | (((lane >> 2) & 3) << 6) | (((lane >> 4) & 1) << 5) | (((lane >> 5) & 1) << 8); }
constexpr int v_rd_off(int d0, int ks, int half) { return d0 * 512 + ks * 2048 + half * 1024; }
template <int OFF> __device__ __forceinline__ s16x4 tr_read(int vb) {
    s16x4 r; asm volatile("ds_read_b64_tr_b16 %0, %1 offset:%2" : "=&v"(r) : "v"(vb), "i"(OFF) : "memory"); return r;
}
template <int D0> __device__ __forceinline__ void pv_one(f32x16& od, int vb, bf16x8 pa0, bf16x8 pa1, bf16x8 pa2, bf16x8 pa3) {
    const s16x4 l0 = tr_read<v_rd_off(D0, 0, 0)>(vb), h0 = tr_read<v_rd_off(D0, 0, 1)>(vb), l1 = tr_read<v_rd_off(D0, 1, 0)>(vb), h1 = tr_read<v_rd_off(D0, 1, 1)>(vb);
    const s16x4 l2 = tr_read<v_rd_off(D0, 2, 0)>(vb), h2 = tr_read<v_rd_off(D0, 2, 1)>(vb), l3 = tr_read<v_rd_off(D0, 3, 0)>(vb), h3 = tr_read<v_rd_off(D0, 3, 1)>(vb);
    asm volatile("s_waitcnt lgkmcnt(0)" ::: "memory"); SBAR();
#define PK(L, H) (bf16x8){L[0], L[1], L[2], L[3], H[0], H[1], H[2], H[3]}
    od = __builtin_amdgcn_mfma_f32_32x32x16_bf16(pa0, PK(l0, h0), od, 0, 0, 0);
    od = __builtin_amdgcn_mfma_f32_32x32x16_bf16(pa1, PK(l1, h1), od, 0, 0, 0);
    od = __builtin_amdgcn_mfma_f32_32x32x16_bf16(pa2, PK(l2, h2), od, 0, 0, 0);
    od = __builtin_amdgcn_mfma_f32_32x32x16_bf16(pa3, PK(l3, h3), od, 0, 0, 0);
#undef PK
}
__device__ __forceinline__ void pv_d0(f32x16* o, int vb, bf16x8 pa0, bf16x8 pa1, bf16x8 pa2, bf16x8 pa3) {
    pv_one<0>(o[0], vb, pa0, pa1, pa2, pa3); pv_one<1>(o[1], vb, pa0, pa1, pa2, pa3);
}
__device__ __forceinline__ void attn_unit(const bf16_t* __restrict__ Qb, const bf16_t* __restrict__ Kh, const bf16_t* __restrict__ Vh, bf16_t* __restrict__ Ob, int nkeys, char* lds) {
    const int tid = tid_fresh(), wid = tid >> 6, lane = tid & 63, r32 = lane & 31, hi = lane >> 5;
    char* V_lds = lds; char* K_lds = lds + 3 * SHM_V;
    float* ws = (float*)(lds + 3 * SHM_V + 3 * SHM_K) + wid * 64; float* li_l = ws; float* al_l = ws + 32;
    float m_reg = 0.f, l_reg = 0; f32x16 o[2] = {}; bf16x8 qr[6]; f32x16 negm = f32x16{};
    const bf16_t* Qw = Qb + (size_t)(wid * QBLK + r32) * DQK + hi * 8;
#pragma unroll
    for (int d0 = 0; d0 < 6; ++d0) qr[d0] = *reinterpret_cast<const bf16x8*>(Qw + d0 * 16);
    const int kid0 = tid, kid1 = 512 + tid; const bool k1 = tid < 256;
    const int kst0 = KSWZ(kid0 / 12, (kid0 % 12) * 16), kst1 = KSWZ(kid1 / 12, (kid1 % 12) * 16);
    const int vst0 = v_st(tid >> 3, (tid & 7) * 8);
    const int vb0 = (int)(uintptr_t)V_lds + v_rd_base(lane);
    const char* Kg = (const char*)Kh; const char* Vg = (const char*)Vh;
    bf16x8 sA_v, sA_k0, sA_k1, sB_v, sB_k0, sB_k1;
    sA_k1 = bf16x8{}; sB_k1 = bf16x8{};
#define SLOAD_A(kt) do { sA_v = *(const bf16x8*)(Vg + (size_t)(kt) * (KVBLK * DV * 2) + tid * 16); sA_k0 = *(const bf16x8*)(Kg + (size_t)(kt) * (KVBLK * DQK * 2) + kid0 * 16); \
    if (k1) sA_k1 = *(const bf16x8*)(Kg + (size_t)(kt) * (KVBLK * DQK * 2) + kid1 * 16); } while (0)
#define SLOAD_B(kt) do { sB_v = *(const bf16x8*)(Vg + (size_t)(kt) * (KVBLK * DV * 2) + tid * 16); sB_k0 = *(const bf16x8*)(Kg + (size_t)(kt) * (KVBLK * DQK * 2) + kid0 * 16); \
    if (k1) sB_k1 = *(const bf16x8*)(Kg + (size_t)(kt) * (KVBLK * DQK * 2) + kid1 * 16); } while (0)
#define SWRITE_A(b) do { *(bf16x8*)(V_lds + (b) * SHM_V + vst0) = sA_v; *(bf16x8*)(K_lds + (b) * SHM_K + kst0) = sA_k0; if (k1) *(bf16x8*)(K_lds + (b) * SHM_K + kst1) = sA_k1; } while (0)
#define SWRITE_B(b) do { *(bf16x8*)(V_lds + (b) * SHM_V + vst0) = sB_v; *(bf16x8*)(K_lds + (b) * SHM_K + kst0) = sB_k0; if (k1) *(bf16x8*)(K_lds + (b) * SHM_K + kst1) = sB_k1; } while (0)
#define RESC(a) do { if (__any((a) < 1.f)) { if (hi == 0) al_l[r32] = (a); asm volatile("s_waitcnt lgkmcnt(0)" ::: "memory"); \
    _Pragma("unroll") for (int d = 0; d < 2; ++d) _Pragma("unroll") for (int r = 0; r < 16; ++r) o[d][r] *= al_l[crow(r, hi)]; } } while (0)
    f32x16 pA0, pA1, pB0, pB1; float alA, alB; bf16x8 pa0, pa1, pa2, pa3; const int NT = nkeys / KVBLK;
    int kcur = 0, kprev = 0, knext = 1;
#define ROT3() do { kprev = kcur; kcur = knext; knext = (knext == 2) ? 0 : knext + 1; } while (0)
    SLOAD_A(0); asm volatile("s_waitcnt vmcnt(0)" ::: "memory"); SWRITE_A(0); __syncthreads();
    qkt(pA0, pA1, K_lds, qr, negm, r32, hi); partialSM<true>(pA0, pA1, m_reg, alA, negm);
    SLOAD_B(1); if (2 < NT) SLOAD_A(2);
    SWRITE_B(1); __syncthreads();
    kcur = 1; kprev = 0; knext = 2;
    for (int j = 1; j + 1 < NT; j += 2) {
        SBAR(); qkt(pB0, pB1, K_lds + kcur * SHM_K, qr, negm, r32, hi);
        finishSM(pA0, pA1, alA, l_reg, pa0, pa1, pa2, pa3); SBAR();
        SLOAD_B(j + 2); SBAR();
        pv_d0(o, vb0 + kprev * SHM_V, pa0, pa1, pa2, pa3); partialSM<false>(pB0, pB1, m_reg, alB, negm);
        SWRITE_A(knext);
        RESC(alB); __syncthreads(); ROT3();
        SBAR(); qkt(pA0, pA1, K_lds + kcur * SHM_K, qr, negm, r32, hi);
        finishSM(pB0, pB1, alB, l_reg, pa0, pa1, pa2, pa3); SBAR();
        if (j + 3 < NT) SLOAD_A(j + 3); SBAR();
        pv_d0(o, vb0 + kprev * SHM_V, pa0, pa1, pa2, pa3); partialSM<false>(pA0, pA1, m_reg, alA, negm);
        SWRITE_B(knext);
        RESC(alA); __syncthreads(); ROT3();
    }
    SBAR(); qkt(pB0, pB1, K_lds + kcur * SHM_K, qr, negm, r32, hi);
    finishSM(pA0, pA1, alA, l_reg, pa0, pa1, pa2, pa3); SBAR();
    pv_d0(o, vb0 + kprev * SHM_V, pa0, pa1, pa2, pa3); partialSM<false>(pB0, pB1, m_reg, alB, negm);
    RESC(alB);
    finishSM(pB0, pB1, alB, l_reg, pa0, pa1, pa2, pa3); SBAR();
    pv_d0(o, vb0 + kcur * SHM_V, pa0, pa1, pa2, pa3);
#undef ROT3
    if (hi == 0) li_l[r32] = l_reg; asm volatile("s_waitcnt lgkmcnt(0)" ::: "memory");
    float rli[16];
#pragma unroll
    for (int r = 0; r < 16; ++r) rli[r] = __builtin_amdgcn_rcpf(li_l[crow(r, hi)]);
    bf16_t* Ow = Ob + (size_t)(wid * QBLK) * 512;
#pragma unroll
    for (int r = 0; r < 16; ++r) { const int orow = crow(r, hi);
#pragma unroll
        for (int d0 = 0; d0 < 2; ++d0) Ow[(size_t)orow * 512 + d0 * 32 + r32] = (bf16_t)(cvt_pk_bf16(o[d0][r] * rli[r], 0.f) & 0xffffu); }
    __syncthreads();
#undef SLOAD_A
#undef SLOAD_B
#undef SWRITE_A
#undef SWRITE_B
#undef RESC
}

__device__ __forceinline__ void phase_mod(const Params& p, LAS unsigned char* lds) {
    float* mod = (float*)(p.ws + WS_MOD);
    const int tid = tid_fresh();
    if (blockIdx.x == 0) { float* rope = (float*)(p.ws + WS_ROPE);
        for (int i = tid; i < 1024; i += 512) { const int pos = i >> 3, f = i & 7; const float inv = powf(10000.f, -(float)(2 * f) / 16.f); const float ang = (float)pos * inv;
            rope[i] = cosf(ang); rope[1024 + i] = sinf(ang); } }
    LAS float* red = (LAS float*)lds;
    const int cq = tid & 127, ks = tid >> 7;
    for (int it = blockIdx.x; it < 2 * 8 * 12; it += gridDim.x) {
        const int l = it / 96, r = it % 96, kc = r / 12, nb = r % 12; const int n = nb * 512 + cq * 4; const int kbase = kc * 128 + ks * 32;
        const float* w = p.w_mod + ((size_t)l * D + kbase) * NMOD + n;
        f32x4 wv[32];
#pragma unroll
        for (int k = 0; k < 32; ++k) wv[k] = *(const f32x4*)(w + (size_t)k * NMOD);
        f32x4 a0 = {0.f, 0.f, 0.f, 0.f}, a1 = a0, a2 = a0;
#pragma unroll
        for (int k = 0; k < 32; ++k) { const int kk = kbase + k; const float c0 = p.c[kk], c1 = p.c[D + kk], c2 = p.c_ctx[kk];
            a0 += wv[k] * (c0 / (1.f + expf(-c0))); a1 += wv[k] * (c1 / (1.f + expf(-c1))); a2 += wv[k] * (c2 / (1.f + expf(-c2))); }
        __syncthreads();
        if (ks > 0) { LAS float* dst = red + ((ks - 1) * 128 + cq) * 12;
            *(LAS f32x4*)dst = a0; *(LAS f32x4*)(dst + 4) = a1; *(LAS f32x4*)(dst + 8) = a2; }
        __syncthreads();
        if (ks == 0) {
#pragma unroll
            for (int q = 0; q < 3; ++q) { const LAS float* src = red + (q * 128 + cq) * 12; a0 += *(const LAS f32x4*)src; a1 += *(const LAS f32x4*)(src + 4); a2 += *(const LAS f32x4*)(src + 8); }
            if (kc == 0) { const f32x4 bv = *(const f32x4*)(p.b_mod + l * NMOD + n); a0 += bv; a1 += bv; a2 += bv; }
#pragma unroll
            for (int i = 0; i < 4; ++i) { atomicAdd(mod + (l * 3 + 0) * NMOD + n + i, a0[i]); atomicAdd(mod + (l * 3 + 1) * NMOD + n + i, a1[i]); atomicAdd(mod + (l * 3 + 2) * NMOD + n + i, a2[i]); }
        }
    }
}
struct TItem { const float* W; bf16_t* WT; const float* ks; int K, N, k0, n0, drow; };
__device__ __forceinline__ TItem wconv_decode(const Params& p, int l, int it) {
    unsigned char* wb = p.ws + WS_W;
    constexpr int I_IN = 16 * 157, I_Q = 6 * 24, I_KV = 4 * 32, I_MO = 8 * 32, I_CO = 4 * 32, I_SO = 4 * 32, I_O = 16 * 32, I_1 = 16 * 88, I_3 = 16 * 88;
    TItem t; t.ks = nullptr; int r = it, nblk;
    if (r < I_IN) { t.W = p.w_in + (size_t)l * D * INC; t.WT = (bf16_t*)(wb + W_IN); t.K = D; t.N = INC; nblk = 157; }
    else if ((r -= I_IN) < I_Q) { t.W = p.w_q_b + (size_t)l * QLORA * 768; t.WT = (bf16_t*)(wb + W_Q); t.K = QLORA; t.N = 768; nblk = 24; t.ks = p.q_g + l * QLORA; }
    else if ((r -= I_Q) < I_KV) { t.W = p.w_kv_b + (size_t)l * KVLORA * 1024; t.WT = (bf16_t*)(wb + W_KV); t.K = KVLORA; t.N = 1024; nblk = 32; t.ks = p.kv_g + l * KVLORA; }
    else if ((r -= I_KV) < I_MO) { t.W = p.w_mla_o + (size_t)l * 512 * 1024; t.WT = (bf16_t*)(wb + W_MO); t.K = 512; t.N = 1024; nblk = 32; }
    else if ((r -= I_MO) < I_CO) { t.W = p.w_conv_o + (size_t)l * 256 * 1024; t.WT = (bf16_t*)(wb + W_CO); t.K = 256; t.N = 1024; nblk = 32; }
    else if ((r -= I_CO) < I_SO) { t.W = p.w_sc_o + (size_t)l * 256 * 1024; t.WT = (bf16_t*)(wb + W_SO); t.K = 256; t.N = 1024; nblk = 32; }
    else if ((r -= I_SO) < I_O) { t.W = p.w_o + (size_t)l * D * D; t.WT = (bf16_t*)(wb + W_O); t.K = D; t.N = D; nblk = 32; }
    else if ((r -= I_O) < I_1) { t.W = p.w_ff1 + (size_t)l * D * DFF; t.WT = (bf16_t*)(wb + W_13); t.K = D; t.N = DFF; nblk = 88; }
    else if ((r -= I_1) < I_3) { t.W = p.w_ff3 + (size_t)l * D * DFF; t.WT = (bf16_t*)(wb + W_13); t.K = D; t.N = DFF; nblk = 88; r += 1 << 20; }
    else { r -= I_3; t.W = p.w_ff2 + (size_t)l * DFF * D; t.WT = (bf16_t*)(wb + W_2); t.K = DFF; t.N = D; nblk = 32; }
    const bool is3 = r >= (1 << 20); r &= (1 << 20) - 1;
    const int kb = r / nblk, nb = r - kb * nblk; t.k0 = kb * 64; t.n0 = nb * 32; t.drow = t.n0;
    if (it < I_IN) t.drow = t.n0 < 1952 ? t.n0 : t.n0 + 96;
    else if (nblk == 88) t.drow = (t.n0 >> 7) * 256 + (t.n0 & 127) + (is3 ? 128 : 0);
    return t;
}
__device__ __forceinline__ void wconv_load(const TItem& t, float (&tv)[32], int lane) {
    const float* src = t.W + (size_t)(t.k0 + (lane >> 5)) * t.N + t.n0 + (lane & 31);
#pragma unroll
    for (int i = 0; i < 32; ++i) tv[i] = src[(size_t)(2 * i) * t.N];
}
__device__ __forceinline__ void wconv_finish(const TItem& t, const float (&tv)[32], LAS float* scr, int lane) {
#pragma unroll
    for (int i = 0; i < 32; ++i) { const int kk = 2 * i + (lane >> 5); float v = tv[i]; if (t.ks) v *= t.ks[t.k0 + kk]; scr[kk * 33 + (lane & 31)] = v; }
    asm volatile("s_waitcnt lgkmcnt(0)" ::: "memory");
    const int c = lane & 7;
#pragma unroll
    for (int j = 0; j < 4; ++j) { const int n = (lane >> 3) + 8 * j; const LAS float* sp = scr + (8 * c) * 33 + n;
        u32x4 o; o.x = cvt_pk_bf16(sp[0 * 33], sp[1 * 33]); o.y = cvt_pk_bf16(sp[2 * 33], sp[3 * 33]); o.z = cvt_pk_bf16(sp[4 * 33], sp[5 * 33]); o.w = cvt_pk_bf16(sp[6 * 33], sp[7 * 33]);
        *(u32x4*)(t.WT + (size_t)(t.drow + n) * t.K + t.k0 + 8 * c) = o; }
    asm volatile("s_waitcnt lgkmcnt(0)" ::: "memory");
}
__device__ __forceinline__ void phase_wconv(const Params& p, int l, LAS unsigned char* lds) {
    const int tid = tid_fresh(), lane = tid & 63, wave = tid >> 6;
    LAS float* scr = (LAS float*)(lds + wave * 16384);
    const int gw = blockIdx.x * 8 + wave, NGW = gridDim.x * 8;
    constexpr int NITEMS = 16 * 157 + 6 * 24 + 4 * 32 + 8 * 32 + 4 * 32 + 4 * 32 + 16 * 32 + 16 * 88 + 16 * 88 + 44 * 32;
#pragma unroll 1
    for (int it = gw; it < NITEMS; it += 2 * NGW) {
        const bool two = it + NGW < NITEMS;
        const TItem t0 = wconv_decode(p, l, it); const TItem t1 = wconv_decode(p, l, two ? it + NGW : it);
        float v0[32], v1[32];
        wconv_load(t0, v0, lane); if (two) wconv_load(t1, v1, lane);
        wconv_finish(t0, v0, scr, lane); if (two) wconv_finish(t1, v1, scr, lane);
    }
    bf16_t* WinT = (bf16_t*)(p.ws + WS_W + W_IN);
    for (int i = blockIdx.x * 512 + tid; i < 12288; i += gridDim.x * 512) *(u32x4*)((unsigned char*)(WinT + (size_t)1952 * D) + (size_t)i * 16) = (u32x4){0u, 0u, 0u, 0u};
}
template <int MODE  , int R>
__device__ __forceinline__ void norm_rows(const Params& p, const float* xL, const float* xC, const float* gain, const float* modl, int jshift, int row0, int lane, float* xc_copy, const float* pb, int nsplit, const float* pg) {
    bf16_t* H = (bf16_t*)(p.ws + WS_H);
    f32x4 v[R][4];
#pragma unroll
    for (int r = 0; r < R; ++r) { const int row = row0 + r; const float* xr = row < ML ? xL + (size_t)row * D : xC + (size_t)(row - ML) * D;
#pragma unroll
        for (int j = 0; j < 4; ++j) v[r][j] = *(const f32x4*)(xr + 4 * lane + 256 * j); }
#pragma unroll
    for (int r = 0; r < R; ++r) { const int row = row0 + r; float ss = 0.f;
        if (MODE == 0 && R == 1 && pb && row >= ML) {
#pragma unroll
            for (int j = 0; j < 4; ++j) { const int c = 4 * lane + 256 * j; f32x4 a = *(const f32x4*)(pb + (size_t)(row - ML) * D + c);
                for (int sp = 1; sp < nsplit; ++sp) a += *(const f32x4*)(pb + ((size_t)sp * MC + (row - ML)) * D + c);
                v[r][j] += *(const f32x4*)(pg + c) * a; } }
#pragma unroll
        for (int j = 0; j < 4; ++j) ss += (v[r][j].x * v[r][j].x + v[r][j].y * v[r][j].y) + (v[r][j].z * v[r][j].z + v[r][j].w * v[r][j].w);
        const float rstd = 1.f / sqrtf(wave_sum(ss) * (1.f / D) + EPS);
        if (MODE == 0) {
            if (R == 1 && xc_copy && row >= ML) {
#pragma unroll
                for (int j = 0; j < 4; ++j) *(f32x4*)(xc_copy + (size_t)(row - ML) * D + 4 * lane + 256 * j) = v[r][j]; }
            const int grp = row < SEQ ? 0 : (row < ML ? 1 : 2); const float* sh = modl + grp * NMOD + jshift * D; const float* sc = sh + D;
#pragma unroll
            for (int j = 0; j < 4; ++j) { const int c = 4 * lane + 256 * j; const f32x4 g = *(const f32x4*)(gain + c), sv = *(const f32x4*)(sc + c), b = *(const f32x4*)(sh + c);
                const f32x4 y = v[r][j] * rstd * g * (sv + 1.f) + b;
                u32x2 w; w.x = cvt_pk_bf16(y.x, y.y); w.y = cvt_pk_bf16(y.z, y.w); *(u32x2*)(H + (size_t)row * D + c) = w; }
        } else {
#pragma unroll
            for (int j = 0; j < 4; ++j) { const int c = 4 * lane + 256 * j; const f32x4 g = *(const f32x4*)(gain + c); *(f32x4*)(p.out + (size_t)row * D + c) = v[r][j] * rstd * g; }
        }
    }
}
template <int MODE>
__device__ __forceinline__ void phase_norm(const Params& p, const float* xL, const float* xC, const float* gain, const float* modl, int jshift, int nrows, float* xc_copy = nullptr, const float* pb = nullptr, int nsplit = 0, const float* pg = nullptr) {
    const int tid = tid_fresh(), lane = tid & 63, wave = tid >> 6; const int gw = blockIdx.x * 8 + wave, NGW = gridDim.x * 8;
    int ngrp = ((nrows >> 3) / NGW) * NGW; if (ngrp > ML / 8) ngrp = ML / 8;
    for (int g = gw; g < ngrp; g += NGW) norm_rows<MODE, 8>(p, xL, xC, gain, modl, jshift, g * 8, lane, xc_copy, pb, nsplit, pg);
    for (int r = ngrp * 8 + gw; r < nrows; r += NGW) norm_rows<MODE, 1>(p, xL, xC, gain, modl, jshift, r, lane, xc_copy, pb, nsplit, pg);
}
__device__ __forceinline__ void phase_prep(const Params& p, int l, LAS unsigned char* lds, const float* kvslab) {
    const int tid = tid_fresh(), lane = tid & 63, wave = tid >> 6;
    const bf16_t* P1 = (const bf16_t*)(p.ws + WS_P1);
    bf16_t* QN = (bf16_t*)(p.ws + WS_QN); bf16_t* CKV = (bf16_t*)(p.ws + WS_CKV); bf16_t* CACT = (bf16_t*)(p.ws + WS_CACT); bf16_t* SACT = (bf16_t*)(p.ws + WS_SACT);
    bf16_t* KR = (bf16_t*)(p.ws + WS_KR); const float* rope = (const float*)(p.ws + WS_ROPE);
    LAS float* Gs = (LAS float*)lds;
    LAS float* Ss = (LAS float*)(lds + 62 * 1024);
    LAS float* Us = (LAS float*)(lds + 96 * 1024);
    const int c = tid & 255, tsub = tid >> 8;
    float dw[31];
#pragma unroll
    for (int w = 0; w < 31; ++w) dw[w] = p.conv_dw[((size_t)l * 31 + w) * 256 + c];
    const float dwb = p.conv_dw_b[l * 256 + c];
    const float s0 = p.sc_dw[((size_t)l * 3 + 0) * 256 + c], s1 = p.sc_dw[((size_t)l * 3 + 1) * 256 + c], s2 = p.sc_dw[((size_t)l * 3 + 2) * 256 + c];
    const float* lng = p.conv_ln_g + l * 256; const float* lnb = p.conv_ln_b + l * 256;
    constexpr int NCH = ML / 32 + MC / 8;
    u32x4 ga[4], gg[4], sa[3], sg[3];
#define PREP_GEOM(ch_) const int T = (ch_) < ML / 32 ? 32 : 8; const int row0 = (ch_) < ML / 32 ? (ch_) * 32 : ML + ((ch_) - ML / 32) * 8; const bool lat = row0 < ML; \
        const int seqbase = lat ? (row0 & ~(SEQ - 1)) : ML + ((row0 - ML) & ~(CTX - 1)); const int L = lat ? SEQ : CTX; const int t0 = row0 - seqbase;
#define PREP_LOAD(ch_) do { PREP_GEOM(ch_) \
        _Pragma("unroll") for (int k = 0; k < 4; ++k) { const int it = tid + 512 * k; const int r = it >> 5, o8 = (it & 31) * 8; const int t = t0 - 15 + r; \
            if (it < (T + 30) * 32 && t >= 0 && t < L) { const bf16_t* src = P1 + (size_t)(seqbase + t) * NP1; ga[k] = *(const u32x4*)(src + 672 + o8); gg[k] = *(const u32x4*)(src + 928 + o8); } } } while (0)
    if ((int)blockIdx.x < NCH) PREP_LOAD((int)blockIdx.x);
    for (int ch = blockIdx.x; ch < NCH; ch += gridDim.x) {
        PREP_GEOM(ch)
        __syncthreads();
#pragma unroll
        for (int k = 0; k < 3; ++k) { const int it = tid + 512 * k; const int r = it >> 5, o8 = (it & 31) * 8; const int t = t0 - 1 + r;
            if (it < (T + 2) * 32 && t >= 0 && t < L) { const bf16_t* src = P1 + (size_t)(seqbase + t) * NP1; sa[k] = *(const u32x4*)(src + 1440 + o8); sg[k] = *(const u32x4*)(src + 1696 + o8); } }
#pragma unroll
        for (int k = 0; k < 4; ++k) { const int it = tid + 512 * k; const int r = it >> 5, o8 = (it & 31) * 8; const int t = t0 - 15 + r;
            if (it < (T + 30) * 32) { LAS float* dst = Gs + r * 256 + o8;
                if (t >= 0 && t < L) { const u32x4 a = ga[k], g = gg[k];
                    dst[0] = bflo(a.x) * sigmoidf_(bflo(g.x)); dst[1] = bfhi(a.x) * sigmoidf_(bfhi(g.x)); dst[2] = bflo(a.y) * sigmoidf_(bflo(g.y)); dst[3] = bfhi(a.y) * sigmoidf_(bfhi(g.y));
                    dst[4] = bflo(a.z) * sigmoidf_(bflo(g.z)); dst[5] = bfhi(a.z) * sigmoidf_(bfhi(g.z)); dst[6] = bflo(a.w) * sigmoidf_(bflo(g.w)); dst[7] = bfhi(a.w) * sigmoidf_(bfhi(g.w));
                } else {
#pragma unroll
                    for (int i = 0; i < 8; ++i) dst[i] = 0.f; } } }
#pragma unroll
        for (int k = 0; k < 3; ++k) { const int it = tid + 512 * k; const int r = it >> 5, o8 = (it & 31) * 8; const int t = t0 - 1 + r;
            if (it < (T + 2) * 32) { LAS float* dst = Ss + r * 256 + o8;
                if (t >= 0 && t < L) { const u32x4 a = sa[k], g = sg[k];
                    dst[0] = bflo(a.x) * bflo(g.x); dst[1] = bfhi(a.x) * bfhi(g.x); dst[2] = bflo(a.y) * bflo(g.y); dst[3] = bfhi(a.y) * bfhi(g.y);
                    dst[4] = bflo(a.z) * bflo(g.z); dst[5] = bfhi(a.z) * bfhi(g.z); dst[6] = bflo(a.w) * bflo(g.w); dst[7] = bfhi(a.w) * bfhi(g.w);
                } else {
#pragma unroll
                    for (int i = 0; i < 8; ++i) dst[i] = 0.f; } } }
        __syncthreads();
        if (ch + (int)gridDim.x < NCH) PREP_LOAD(ch + (int)gridDim.x);
        unsigned short bgv[16];
#pragma unroll
        for (int tt = 0; tt < 16; ++tt) if (tt * 2 < T) bgv[tt] = P1[(size_t)(row0 + tt * 2 + tsub) * NP1 + 1184 + c];
#pragma unroll
        for (int tt = 0; tt < 16; ++tt) if (tt * 2 < T) { const int tok = tt * 2 + tsub; float u = dwb;
#pragma unroll
            for (int w = 0; w < 31; ++w) u += dw[w] * Gs[(tok + w) * 256 + c];
            Us[tok * 256 + c] = u;
            const float sv = s0 * Ss[tok * 256 + c] + s1 * Ss[(tok + 1) * 256 + c] + s2 * Ss[(tok + 2) * 256 + c];
            const float bg = bf2f(bgv[tt]);
            SACT[(size_t)(row0 + tok) * 256 + c] = (bf16_t)(cvt_pk_bf16(bg * sv, 0.f) & 0xffffu); }
        __syncthreads();
#pragma unroll
        for (int q = 0; q < 4; ++q) if (q * 8 < T) { const int tok = wave + 8 * q; const int row = row0 + tok; const bf16_t* src = P1 + (size_t)row * NP1;
            { const f32x4 u = *(const LAS f32x4*)(Us + tok * 256 + 4 * lane); const float mu = wave_sum((u.x + u.y) + (u.z + u.w)) * (1.f / 256.f);
              const f32x4 d = u - mu; const float var = wave_sum((d.x * d.x + d.y * d.y) + (d.z * d.z + d.w * d.w)) * (1.f / 256.f); const float rstd = 1.f / sqrtf(var + EPS);
              const f32x4 g = *(const f32x4*)(lng + 4 * lane), b = *(const f32x4*)(lnb + 4 * lane); f32x4 y = d * rstd * g + b;
              y.x = siluf_(y.x); y.y = siluf_(y.y); y.z = siluf_(y.z); y.w = siluf_(y.w);
              u32x2 w; w.x = cvt_pk_bf16(y.x, y.y); w.y = cvt_pk_bf16(y.z, y.w); *(u32x2*)(CACT + (size_t)row * 256 + 4 * lane) = w; }
            { const u32x2 a = *(const u32x2*)(src + 4 * lane); const unsigned b2 = *(const unsigned*)(src + 256 + 2 * lane);
              const float x0 = bflo(a.x), x1 = bfhi(a.x), x2 = bflo(a.y), x3 = bfhi(a.y), x4 = bflo(b2), x5 = bfhi(b2);
              const float ss = wave_sum((x0 * x0 + x1 * x1) + (x2 * x2 + x3 * x3) + (x4 * x4 + x5 * x5)); const float rstd = 1.f / sqrtf(ss * (1.f / 384.f) + EPS);
              u32x2 w; w.x = cvt_pk_bf16(x0 * rstd, x1 * rstd); w.y = cvt_pk_bf16(x2 * rstd, x3 * rstd); *(u32x2*)(QN + (size_t)row * QLORA + 4 * lane) = w;
              *(unsigned*)(QN + (size_t)row * QLORA + 256 + 2 * lane) = cvt_pk_bf16(x4 * rstd, x5 * rstd); }
            { float x0, x1, x2, x3;
              if (q == 0 && kvslab && !lat) { f32x4 a4 = *(const f32x4*)(kvslab + (size_t)(row - ML) * 512 + 128 + 4 * lane);
#pragma unroll
                  for (int sp = 1; sp < 4; ++sp) a4 += *(const f32x4*)(kvslab + ((size_t)sp * MC + (row - ML)) * 512 + 128 + 4 * lane);
                  x0 = a4.x; x1 = a4.y; x2 = a4.z; x3 = a4.w; }
              else { const u32x2 a = *(const u32x2*)(src + 384 + 4 * lane); x0 = bflo(a.x); x1 = bfhi(a.x); x2 = bflo(a.y); x3 = bfhi(a.y); }
              const float ss = wave_sum((x0 * x0 + x1 * x1) + (x2 * x2 + x3 * x3)); const float rstd = 1.f / sqrtf(ss * (1.f / 256.f) + EPS);
              u32x2 w; w.x = cvt_pk_bf16(x0 * rstd, x1 * rstd); w.y = cvt_pk_bf16(x2 * rstd, x3 * rstd); *(u32x2*)(CKV + (size_t)row * 256 + 4 * lane) = w; }
            { int b, qi; row_to_bq(row, b, qi); const int j = lane & 31; float v;
              if (q == 0 && kvslab && !lat) { v = 0.f;
#pragma unroll
                  for (int sp = 0; sp < 4; ++sp) v += kvslab[((size_t)sp * MC + (row - ML)) * 512 + 384 + j]; }
              else v = bf2f(src[640 + j]);
              const float pv = __shfl_xor(v, 8);
              if (lat) { const int pos = (j >> 4) ? (qi & 63) : (qi >> 6); const int f = j & 7; const float cs = rope[pos * 8 + f], sn = rope[1024 + pos * 8 + f];
                  v = (j & 8) ? pv * sn + v * cs : v * cs - pv * sn; }
              const bf16_t o = (bf16_t)(cvt_pk_bf16(v, 0.f) & 0xffffu);
              if (lane < 32) KR[(size_t)row * 32 + j] = o; }
        }
    }
}

#undef PREP_GEOM
#undef PREP_LOAD
#define XB_TMO      128
#define XB_XCNT(j)  (256  + 64 * (j))
#define XB_XSUB(j)  (1280 + 64 * (j))
#define XB_XGEN(j)  (2304 + 64 * (j))
#define XB_TOP      3328
#define XB_TOPGEN   3392
#define XCD_BAR_WORDS 3456
#define XB_SPIN_CAP (1u << 18)

__device__ __forceinline__ unsigned xb_ld(unsigned* p)              { return __hip_atomic_load(p, __ATOMIC_RELAXED, __HIP_MEMORY_SCOPE_AGENT); }
__device__ __forceinline__ unsigned xb_add(unsigned* p, unsigned v) { return __hip_atomic_fetch_add(p, v, __ATOMIC_RELAXED, __HIP_MEMORY_SCOPE_AGENT); }
__device__ __forceinline__ unsigned xb_xcc_id() { return (unsigned)__builtin_amdgcn_s_getreg((3 << 11) | 20) & 0xFu; }
#define XB_SPIN(cond, bar) do { unsigned _sp = 0; while (cond) { __builtin_amdgcn_s_sleep(1); \
    if ((++_sp & 255u) == 0u) { if (xb_ld(&(bar)[XB_TMO])) break; if (_sp > XB_SPIN_CAP) { atomicAdd(&(bar)[XB_TMO], 1u); break; } } } } while (0)

struct XcdBarrier {
    unsigned* bar; unsigned x;
    volatile LAS unsigned* st;
};

__device__ __forceinline__ XcdBarrier xcd_barrier_post(unsigned* bar, volatile LAS unsigned* st) {
    XcdBarrier b; b.bar = bar; b.x = xb_xcc_id(); b.st = st;
    if (threadIdx.x == 0) (void)xb_add(&bar[XB_XCNT(b.x)], 1u);
    return b;
}
__device__ __forceinline__ void xcd_barrier_complete(unsigned* bar, unsigned x, unsigned& nloc, unsigned& nx) {
    const unsigned G = gridDim.x * gridDim.y * gridDim.z;
    unsigned sum, cnt, mine, sp = 0u;
    for (;;) {
        sum = 0u; cnt = 0u; mine = 0u;
#pragma unroll
        for (unsigned j = 0; j < 16; ++j) { const unsigned c = xb_ld(&bar[XB_XCNT(j)]); sum += c; cnt += (c > 0u) ? 1u : 0u; mine = (j == x) ? c : mine; }
        if (sum == G) break;
        __builtin_amdgcn_s_sleep(1);
        if ((++sp & 255u) == 0u) { if (xb_ld(&bar[XB_TMO])) break; if (sp > XB_SPIN_CAP) { atomicAdd(&bar[XB_TMO], 1u); break; } }
    }
    nloc = mine > 0u ? mine : 1u; nx = cnt > 0u ? cnt : 1u;
}

__device__ __forceinline__ void xcd_barrier(const XcdBarrier& b) {
    asm volatile("s_waitcnt vmcnt(0)" ::: "memory");
    __syncthreads();
    if (threadIdx.x == 0) {
        unsigned* bar = b.bar;
        __builtin_amdgcn_s_waitcnt(0);
        unsigned nloc = b.st[0], nx = b.st[1];
        if (nloc == 0u) { xcd_barrier_complete(bar, b.x, nloc, nx); b.st[0] = nloc; b.st[1] = nx; }
        const unsigned old = xb_add(&bar[XB_XSUB(b.x)], 1u);
        const unsigned gen = old / nloc;
        if (old + 1u == (gen + 1u) * nloc) {
            __builtin_amdgcn_fence(__ATOMIC_RELEASE, "agent");
            asm volatile("s_waitcnt vmcnt(0)" ::: "memory");
            const unsigned og = xb_add(&bar[XB_TOP], 1u);
            const unsigned tg = og / nx;
            if (og + 1u == (tg + 1u) * nx) xb_add(&bar[XB_TOPGEN], 1u);
            else XB_SPIN(xb_ld(&bar[XB_TOPGEN]) == tg, bar);
            __builtin_amdgcn_fence(__ATOMIC_ACQUIRE, "agent");
            xb_add(&bar[XB_XGEN(b.x)], 1u);
            asm volatile("s_waitcnt vmcnt(0)" ::: "memory");
        } else {
            XB_SPIN(xb_ld(&bar[XB_XGEN(b.x)]) == gen, bar);
            __builtin_amdgcn_fence(__ATOMIC_ACQUIRE, "agent");
            asm volatile("s_waitcnt vmcnt(0)" ::: "memory");
        }
    }
    __syncthreads();
}

__global__ void __launch_bounds__(512, 2) mega_fwd(Params p) {
    extern __shared__ __attribute__((aligned(16))) unsigned char lds_raw[];
    LAS unsigned char* lds = (LAS unsigned char*)lds_raw;
    cg::grid_group grid = cg::this_grid();
    { volatile LAS unsigned* st0 = (volatile LAS unsigned*)(lds + 131072 + 64); if (threadIdx.x < 2) st0[threadIdx.x] = 0u; __syncthreads(); }
    XcdBarrier xbar = xcd_barrier_post((unsigned*)(p.ws + WS_BAR), (volatile LAS unsigned*)(lds + 131072 + 64));
    unsigned char* ws = p.ws;
    const float* modall = (const float*)(ws + WS_MOD);
    float* XC = (float*)(ws + WS_XCTX);
    bf16_t* WinT = (bf16_t*)(ws + WS_W + W_IN); bf16_t* WqT = (bf16_t*)(ws + WS_W + W_Q); bf16_t* WkvT = (bf16_t*)(ws + WS_W + W_KV); bf16_t* WmoT = (bf16_t*)(ws + WS_W + W_MO);
    bf16_t* WcoT = (bf16_t*)(ws + WS_W + W_CO); bf16_t* WsoT = (bf16_t*)(ws + WS_W + W_SO); bf16_t* WoT = (bf16_t*)(ws + WS_W + W_O); bf16_t* W13T = (bf16_t*)(ws + WS_W + W_13); bf16_t* W2T = (bf16_t*)(ws + WS_W + W_2);
    bf16_t* GATES = (bf16_t*)(ws + WS_GATES); bf16_t* ACT = (bf16_t*)(ws + WS_GATES); bf16_t* P1 = (bf16_t*)(ws + WS_P1); bf16_t* H = (bf16_t*)(ws + WS_H);
    bf16_t* Qb = (bf16_t*)(ws + WS_Q); bf16_t* Kb = (bf16_t*)(ws + WS_K); bf16_t* Vb = (bf16_t*)(ws + WS_V); bf16_t* T = (bf16_t*)(ws + WS_T);
    float* PB = (float*)(ws + WS_PB); float* PB2 = (float*)(ws + WS_ATT);
    bf16_t* QN = (bf16_t*)(ws + WS_QN); bf16_t* CKV = (bf16_t*)(ws + WS_CKV); bf16_t* CACT = (bf16_t*)(ws + WS_CACT); bf16_t* SACT = (bf16_t*)(ws + WS_SACT); bf16_t* ATT = (bf16_t*)(ws + WS_ATT);
    const int G = gridDim.x, cb = blockIdx.x;
    int ph = 0;
#define PHASE_BEGIN if (ph >= p.ph_lo && ph < p.ph_hi) { const int nrep_ = ((REPMASK >> ph) & 1) ? 2 : 1; for (int rep_ = 0; rep_ < nrep_; ++rep_) {
#define PHASE_END   if (ph + 1 < p.ph_hi || rep_ + 1 < nrep_) { if (p.ph_hi < 0) grid.sync(); else xcd_barrier(xbar); } } } ++ph;
#ifdef NO_GEMM
#define GEMM(ID, EpiT, Aptr, Bptr, M_, N_, K_, epi) do {} while (0)
#else
#define GEMM(ID, EpiT, Aptr, Bptr, M_, N_, K_, epi) do { if (ONLY_GEMM && ONLY_GEMM != ID) break; pg8::Gemm g_{Aptr, Bptr, M_, N_, K_, K_}; pg8::StaticOrder S_; S_.init(M_, N_, G, cb); \
        pg8::gemm_phase<EpiT, pg8::StaticOrder, true, true>(lds, g_, S_, epi); } while (0)
#endif

    for (int i_ = 0; i_ < NSYNC_EXTRA; ++i_) grid.sync();
    PHASE_BEGIN phase_mod(p, lds); PHASE_END
#pragma unroll 1
    for (int l = 0; l < DEPTH; ++l) {
        const bool last = (l == DEPTH - 1);
        const float* modl = modall + (size_t)l * 3 * NMOD;
        const float* xinL = (l == 0) ? p.x : p.out; const float* xinC = (l == 0) ? p.ctx : XC;
        const int Mfull = MT, Mlat = last ? ML : MT;
        PHASE_BEGIN phase_wconv(p, l, lds); if (l == 0) phase_norm<0>(p, xinL, xinC, p.ln1_g + l * D, modl, 0, MT, XC);
                    else phase_norm<0>(p, xinL, xinC, p.ln1_g + l * D, modl, 0, MT, XC, PB, 11, modall + (size_t)(l - 1) * 3 * NMOD + 2 * NMOD + 5 * D); PHASE_END
        PHASE_BEGIN { EpiProj e{P1, GATES};
                      if (!last) { GEMM(1, EpiProj, H, WinT, MT, NIN, D, e); }
                      else { GEMM(1, EpiProj, H, WinT, ML, NIN, D, e);
                             EpiPartialKV ek{PB2}; pg8::Gemm g_{H, WinT, MT, NIN, 256, D}; CtxKvOrder S_{G, cb};
                             pg8::gemm_phase<EpiPartialKV, CtxKvOrder, true, true>(lds, g_, S_, ek); } } PHASE_END
#ifndef NO_PREP
        PHASE_BEGIN phase_prep(p, l, lds, last ? PB2 : nullptr); PHASE_END
#endif
        PHASE_BEGIN { EpiQ eq{Qb, (const float*)(ws + WS_ROPE)}; GEMM(2, EpiQ, QN, WqT, Mlat, 768, QLORA, eq); EpiKV ek{Kb, Vb, (const bf16_t*)(ws + WS_KR)};
                      { pg8::Gemm g_{CKV, WkvT, Mfull, 1024, KVLORA, KVLORA}; pg8::StaticOrder S_; S_.init(Mfull, 1024, G, (cb + 58) % G);
                        pg8::gemm_phase<EpiKV, pg8::StaticOrder, true, true>(lds, g_, S_, ek); } } PHASE_END
#ifndef NO_ATTN
        PHASE_BEGIN {
            const int nunits = 512 + (last ? 0 : 16);
#pragma unroll 1
            for (int u = cb; u < nunits; u += G) {
                if (u < 512) { const int i = u >> 8, c8 = u & 255; const int bh = (c8 & 7) + 8 * i, qb = c8 >> 3; const int b = bh >> 3, h = bh & 7;
                    attn_unit(Qb + ((size_t)bh * NKEY + qb * 256) * DQK, Kb + (size_t)bh * NKEY * DQK, Vb + (size_t)bh * NKEY * DV, ATT + (size_t)(b * SEQ + qb * 256) * 512 + h * 64, NKEY, (char*)lds_raw); }
                else { const int bh = u - 512, b = bh >> 3, h = bh & 7;
                    attn_unit(Qb + ((size_t)bh * NKEY + SEQ) * DQK, Kb + ((size_t)bh * NKEY + SEQ) * DQK, Vb + ((size_t)bh * NKEY + SEQ) * DV, ATT + (size_t)(ML + b * CTX) * 512 + h * 64, CTX, (char*)lds_raw); }
            }
        } PHASE_END
#endif
        PHASE_BEGIN { EpiMerge<0> e0{T, GATES, 1}; GEMM(4, EpiMerge<0>, CACT, WcoT, Mlat, D, 256, e0); EpiMerge<1> e1{T, GATES, 2}; GEMM(5, EpiMerge<1>, SACT, WsoT, Mlat, D, 256, e1);
                      EpiMerge<1> e2{T, GATES, 0}; GEMM(6, EpiMerge<1>, ATT, WmoT, Mlat, D, 512, e2); } PHASE_END
        PHASE_BEGIN { EpiResid e{xinL, xinC, p.out, XC, modl + 2 * D}; GEMM(7, EpiResid, T, WoT, ML, D, D, e);
                      if (!last) { EpiPartial ea{PB}; pg8::Gemm g_{T, WoT, MT, D, 256, D}; CtxSplitOrder S_{4, G, cb};
                                   pg8::gemm_phase<EpiPartial, CtxSplitOrder, true, true>(lds, g_, S_, ea); } } PHASE_END
        PHASE_BEGIN if (last) phase_norm<0>(p, p.out, XC, p.ln2_g + l * D, modl, 3, Mlat); else phase_norm<0>(p, p.out, XC, p.ln2_g + l * D, modl, 3, Mlat, XC, PB, 4, modl + 2 * NMOD + 2 * D); PHASE_END
        PHASE_BEGIN { EpiSwiglu e{ACT}; GEMM(8, EpiSwiglu, H, W13T, Mlat, 2 * DFF, D, e); } PHASE_END
        PHASE_BEGIN { EpiResid e{p.out, XC, p.out, XC, modl + 5 * D}; GEMM(9, EpiResid, ACT, W2T, ML, D, DFF, e);
                      if (!last) { EpiPartial ea{PB}; pg8::Gemm g_{ACT, W2T, MT, D, 256, DFF}; CtxSplitOrder S_{11, G, cb};
                                   pg8::gemm_phase<EpiPartial, CtxSplitOrder, true, true>(lds, g_, S_, ea); } } PHASE_END
    }
    PHASE_BEGIN phase_norm<1>(p, p.out, XC, p.final_g, nullptr, 0, ML); PHASE_END
}
constexpr int NPHASES = 1 + DEPTH * 10 + 1;
}

extern "C" void kernel_launch(void* const* d_in, const int* in_sizes, int n_in, void* d_out, int out_size, void* d_ws, size_t ws_size, hipStream_t stream) {
    static int grid = 0;
    if (grid == 0) {
        if (n_in != 26 || out_size != mk::ML * mk::D || ws_size < mk::WS_END) { fprintf(stderr, "kernel_launch: unexpected shapes n_in %d out %d ws %zu (need %zu)\n", n_in, out_size, ws_size, (size_t)mk::WS_END); grid = -1; return; }
        int dev = 0, cus = 0, per_cu = 0;
        hipGetDevice(&dev); hipDeviceGetAttribute(&cus, hipDeviceAttributeMultiprocessorCount, dev);
        if (hipFuncSetAttribute((const void*)mk::mega_fwd, hipFuncAttributeMaxDynamicSharedMemorySize, mk::LDS_BYTES) != hipSuccess) { fprintf(stderr, "kernel_launch: hipFuncSetAttribute failed\n"); grid = -1; return; }
        hipOccupancyMaxActiveBlocksPerMultiprocessor(&per_cu, (const void*)mk::mega_fwd, 512, mk::LDS_BYTES);
        if (per_cu < 1) per_cu = 1;
        grid = cus * per_cu; if (grid > 256) grid = 256;
        (void)hipGetLastError();
        fprintf(stderr, "kernel_launch: cus %d per_cu %d grid %d\n", cus, per_cu, grid);
    }
    if (grid < 0) return;
    hipMemsetAsync(d_ws, 0, mk::WS_ZERO_BYTES, stream);
    mk::Params p{};
    const float** pp = (const float**)&p;
    for (int i = 0; i < 26; ++i) pp[i] = (const float*)d_in[i];
    p.out = (float*)d_out; p.ws = (unsigned char*)d_ws;
#if MK_MULTI
    for (int ph = 0; ph < mk::NPHASES; ++ph) { p.ph_lo = ph; p.ph_hi = ph + 1; hipLaunchKernelGGL(mk::mega_fwd, dim3(grid), dim3(512), mk::LDS_BYTES, stream, p); }
#else
    p.ph_lo = 0; p.ph_hi = mk::NPHASES;
    void* args[] = {&p};
    hipError_t e = hipLaunchCooperativeKernel((const void*)mk::mega_fwd, dim3(grid), dim3(512), args, mk::LDS_BYTES, stream);
    if (e != hipSuccess) fprintf(stderr, "cooperative launch failed: %s (grid %d)\n", hipGetErrorString(e), grid);
#endif
}
```
